# Optimizing an MI355X kernel written in HIP

```python
import jax, jax.numpy as jnp
from jax import lax
import numpy as np

D_MODEL = 2048
BATCH = 2
SEQ = 4096
DEPTH = 1

SGU_WIDTH = D_MODEL // 2
SGU_GROUP_DIM = 128
SGU_GROUPS = SGU_WIDTH // SGU_GROUP_DIM
SGU_CHUNK = 128
RWKV_WIDTH = D_MODEL // 2
RWKV_HEAD_DIM = 64
RWKV_HEADS = RWKV_WIDTH // RWKV_HEAD_DIM
DECAY_LORA = 64
AAA_LORA = 64
GATE_LORA = 160
RWKV_FEAT = 3 * RWKV_WIDTH + 2 * DECAY_LORA + 2 * AAA_LORA + GATE_LORA
IN_WIDTH = 2 * SGU_WIDTH + RWKV_FEAT + 2 * D_MODEL
D_FF = ((8 * D_MODEL // 3 + 255) // 256) * 256
CONV_WIDTH = 3
NORM_EPS = 1e-6
LN_EPS = 1e-5
GN_EPS = 64e-5

kernel_name = 'hybrid_sgu_rwkv7_convglu_encoder'

F32 = jnp.float32


def rms_norm(x, g):
    xf = x.astype(F32)
    y = xf * lax.rsqrt(jnp.mean(xf * xf, axis=-1, keepdims=True) + NORM_EPS)
    return (y * g.astype(F32)).astype(x.dtype)


def layer_norm(x, g, b):
    xf = x.astype(F32)
    mu = jnp.mean(xf, axis=-1, keepdims=True)
    var = jnp.mean(jnp.square(xf - mu), axis=-1, keepdims=True)
    y = (xf - mu) * lax.rsqrt(var + LN_EPS)
    return (y * g.astype(F32) + b.astype(F32)).astype(x.dtype)


def split_cols(t, sizes):
    out, o = [], 0
    for s in sizes:
        out.append(t[..., o:o + s])
        o += s
    return out


def shift_prev(x):
    return jnp.pad(x[:, :-1], ((0, 0), (1, 0), (0, 0)))


def shift_next(x):
    return jnp.pad(x[:, 1:], ((0, 0), (0, 1), (0, 0)))


def sgu_mixer(u, v, ln_g, ln_b, w_s, b_s):
    u = jax.nn.gelu(u, approximate=False)
    v = layer_norm(jax.nn.gelu(v, approximate=False), ln_g, ln_b)
    bsz, seq, _ = v.shape
    v = v.reshape(bsz, seq // SGU_CHUNK, SGU_CHUNK, SGU_GROUPS, SGU_GROUP_DIM)
    mixed = jnp.einsum('gij,bcjgd->bcigd', w_s, v) + b_s.T[None, None, :, :, None]
    return u * mixed.reshape(bsz, seq, SGU_WIDTH)


def wkv7_scan(r, w, k, v, kk, a, reverse):
    bsz, _, h, n = r.shape
    xs = tuple(jnp.moveaxis(t.astype(F32), 1, 0) for t in (r, w, k, v, kk, a))

    def step(state, inp):
        r_t, w_t, k_t, v_t, kk_t, a_t = inp
        sa = jnp.einsum('bhvk,bhk->bhv', state, kk_t)
        state = (state * w_t[:, :, None, :]
                 - sa[..., None] * (kk_t * a_t)[:, :, None, :]
                 + v_t[..., None] * k_t[:, :, None, :])
        return state, jnp.einsum('bhvk,bhk->bhv', state, r_t)

    _, out = lax.scan(step, jnp.zeros((bsz, h, n, n), F32), xs, reverse=reverse)
    return jnp.moveaxis(out, 0, 1)


def rwkv_direction(r, k, v, kk, w_lo, a_lo, w0, w2, a0, a2, k_a, reverse):
    bsz, seq, _ = r.shape
    heads = lambda t: t.reshape(bsz, seq, RWKV_HEADS, RWKV_HEAD_DIM)
    w_raw = -jax.nn.softplus(-(w0 + jnp.tanh(w_lo) @ w2)) - 0.5
    decay = jnp.exp(-jnp.exp(w_raw.astype(F32)))
    a = jax.nn.sigmoid(a0 + a_lo @ a2)
    k_dir = k * (1 + (a - 1) * k_a)
    o = wkv7_scan(heads(r), heads(decay), heads(k_dir), heads(v), kk, heads(a), reverse)
    return o, k_dir


def head_group_norm(o, g, b):
    bsz, seq, _, _ = o.shape
    of = o.astype(F32)
    mu = jnp.mean(of, axis=-1, keepdims=True)
    var = jnp.mean(jnp.square(of - mu), axis=-1, keepdims=True)
    y = ((of - mu) * lax.rsqrt(var + GN_EPS)).reshape(bsz, seq, RWKV_WIDTH)
    return (y * g.astype(F32) + b.astype(F32)).astype(g.dtype)


def rwkv_mixer(feat, mu_prev, mu_next, w0_f, w2_f, a0_f, a2_f, w0_b, w2_b, a0_b, a2_b,
               k_k, k_a, r_k, g2, gn_g, gn_b):
    bsz, seq, _ = feat.shape
    xs = feat + mu_prev * (shift_prev(feat) - feat) + mu_next * (shift_next(feat) - feat)
    r, k, v, wlo_f, wlo_b, alo_f, alo_b, glo = split_cols(
        xs, (RWKV_WIDTH, RWKV_WIDTH, RWKV_WIDTH, DECAY_LORA, DECAY_LORA, AAA_LORA, AAA_LORA, GATE_LORA))
    heads = lambda t: t.reshape(bsz, seq, RWKV_HEADS, RWKV_HEAD_DIM)
    kkf = heads(k * k_k).astype(F32)
    kk = kkf * lax.rsqrt(jnp.maximum(jnp.sum(kkf * kkf, axis=-1, keepdims=True), 1e-24))
    o_f, k_f = rwkv_direction(r, k, v, kk, wlo_f, alo_f, w0_f, w2_f, a0_f, a2_f, k_a, False)
    o_b, k_b = rwkv_direction(r, k, v, kk, wlo_b, alo_b, w0_b, w2_b, a0_b, a2_b, k_a, True)
    o = head_group_norm(o_f + o_b, gn_g, gn_b)
    bonus = jnp.sum(heads(r * (k_f + k_b) * r_k), axis=-1, keepdims=True) * heads(v)
    g = jax.nn.sigmoid(glo) @ g2
    return (o + bonus.reshape(bsz, seq, RWKV_WIDTH)) * g


def dwconv3_centred(x, w, b):
    xp = jnp.pad(x, ((0, 0), (1, 1), (0, 0)))
    return xp[:, :-2] * w[0] + xp[:, 1:-1] * w[1] + xp[:, 2:] * w[2] + b


def hybrid_layer(x, norm1_g, w_in, sgu_ln_g, sgu_ln_b, sgu_w, sgu_b,
                 rwkv_mu_prev, rwkv_mu_next, rwkv_w0_f, rwkv_w2_f, rwkv_a0_f, rwkv_a2_f,
                 rwkv_w0_b, rwkv_w2_b, rwkv_a0_b, rwkv_a2_b, rwkv_k_k, rwkv_k_a, rwkv_r_k,
                 rwkv_g2, rwkv_gn_g, rwkv_gn_b, w_proj_a, w_proj_b, w_out,
                 norm2_g, ffn_w_gate, ffn_w_up, ffn_conv_w, ffn_conv_b, ffn_w_down):
    h = rms_norm(x, norm1_g)
    proj = h @ w_in
    u_a, v_a, feat_b, gate_a, gate_b = split_cols(
        proj, (SGU_WIDTH, SGU_WIDTH, RWKV_FEAT, D_MODEL, D_MODEL))
    y_a = sgu_mixer(u_a, v_a, sgu_ln_g, sgu_ln_b, sgu_w, sgu_b)
    y_b = rwkv_mixer(feat_b, rwkv_mu_prev, rwkv_mu_next, rwkv_w0_f, rwkv_w2_f, rwkv_a0_f, rwkv_a2_f,
                     rwkv_w0_b, rwkv_w2_b, rwkv_a0_b, rwkv_a2_b, rwkv_k_k, rwkv_k_a, rwkv_r_k,
                     rwkv_g2, rwkv_gn_g, rwkv_gn_b)
    merged = jax.nn.sigmoid(gate_a) * (y_a @ w_proj_a) + jax.nn.sigmoid(gate_b) * (y_b @ w_proj_b)
    x = x + merged @ w_out
    h2 = rms_norm(x, norm2_g)
    gt = dwconv3_centred(h2 @ ffn_w_gate, ffn_conv_w, ffn_conv_b)
    x = x + (jax.nn.silu(gt) * (h2 @ ffn_w_up)) @ ffn_w_down
    return x


def setup_inputs(seed: int = 0) -> dict:
    key = jax.random.key(seed)
    ks = iter(jax.random.split(key, 40))
    nrm = lambda shape, s: jax.random.normal(next(ks), shape, F32) * s
    uni = lambda shape, lo, hi: jax.random.uniform(next(ks), shape, F32, lo, hi)
    L = DEPTH
    return {
        'x': nrm((BATCH, SEQ, D_MODEL), 1.0),
        'norm1_g': 1.0 + nrm((L, D_MODEL), 0.02),
        'w_in': nrm((L, D_MODEL, IN_WIDTH), D_MODEL ** -0.5),
        'sgu_ln_g': 1.0 + nrm((L, SGU_WIDTH), 0.02),
        'sgu_ln_b': nrm((L, SGU_WIDTH), 0.02),
        'sgu_w': nrm((L, SGU_GROUPS, SGU_CHUNK, SGU_CHUNK), 0.5 * SGU_CHUNK ** -0.5),
        'sgu_b': 1.0 + nrm((L, SGU_GROUPS, SGU_CHUNK), 0.1),
        'rwkv_mu_prev': uni((L, RWKV_FEAT), 0.0, 0.5),
        'rwkv_mu_next': uni((L, RWKV_FEAT), 0.0, 0.5),
        'rwkv_w0_f': uni((L, RWKV_WIDTH), -5.0, 0.5),
        'rwkv_w2_f': nrm((L, DECAY_LORA, RWKV_WIDTH), 0.3 * DECAY_LORA ** -0.5),
        'rwkv_a0_f': nrm((L, RWKV_WIDTH), 0.1),
        'rwkv_a2_f': nrm((L, AAA_LORA, RWKV_WIDTH), 0.3 * AAA_LORA ** -0.5),
        'rwkv_w0_b': uni((L, RWKV_WIDTH), -5.0, 0.5),
        'rwkv_w2_b': nrm((L, DECAY_LORA, RWKV_WIDTH), 0.3 * DECAY_LORA ** -0.5),
        'rwkv_a0_b': nrm((L, RWKV_WIDTH), 0.1),
        'rwkv_a2_b': nrm((L, AAA_LORA, RWKV_WIDTH), 0.3 * AAA_LORA ** -0.5),
        'rwkv_k_k': 0.85 + nrm((L, RWKV_WIDTH), 0.05),
        'rwkv_k_a': 1.0 + nrm((L, RWKV_WIDTH), 0.05),
        'rwkv_r_k': nrm((L, RWKV_WIDTH), 0.1),
        'rwkv_g2': nrm((L, GATE_LORA, RWKV_WIDTH), GATE_LORA ** -0.5),
        'rwkv_gn_g': 1.0 + nrm((L, RWKV_WIDTH), 0.02),
        'rwkv_gn_b': nrm((L, RWKV_WIDTH), 0.02),
        'w_proj_a': nrm((L, SGU_WIDTH, D_MODEL), SGU_WIDTH ** -0.5),
        'w_proj_b': nrm((L, RWKV_WIDTH, D_MODEL), RWKV_WIDTH ** -0.5),
        'w_out': nrm((L, D_MODEL, D_MODEL), D_MODEL ** -0.5),
        'norm2_g': 1.0 + nrm((L, D_MODEL), 0.02),
        'ffn_w_gate': nrm((L, D_MODEL, D_FF), D_MODEL ** -0.5),
        'ffn_w_up': nrm((L, D_MODEL, D_FF), D_MODEL ** -0.5),
        'ffn_conv_w': nrm((L, CONV_WIDTH, D_FF), CONV_WIDTH ** -0.5),
        'ffn_conv_b': nrm((L, D_FF), 0.02),
        'ffn_w_down': nrm((L, D_FF, D_MODEL), D_FF ** -0.5),
        'norm_f_g': 1.0 + nrm((D_MODEL,), 0.02),
    }


def reference(x, norm1_g, w_in, sgu_ln_g, sgu_ln_b, sgu_w, sgu_b,
              rwkv_mu_prev, rwkv_mu_next, rwkv_w0_f, rwkv_w2_f, rwkv_a0_f, rwkv_a2_f,
              rwkv_w0_b, rwkv_w2_b, rwkv_a0_b, rwkv_a2_b, rwkv_k_k, rwkv_k_a, rwkv_r_k,
              rwkv_g2, rwkv_gn_g, rwkv_gn_b, w_proj_a, w_proj_b, w_out,
              norm2_g, ffn_w_gate, ffn_w_up, ffn_conv_w, ffn_conv_b, ffn_w_down, norm_f_g):
    for d in range(DEPTH):
        x = hybrid_layer(x, norm1_g[d], w_in[d], sgu_ln_g[d], sgu_ln_b[d], sgu_w[d], sgu_b[d],
                         rwkv_mu_prev[d], rwkv_mu_next[d], rwkv_w0_f[d], rwkv_w2_f[d],
                         rwkv_a0_f[d], rwkv_a2_f[d], rwkv_w0_b[d], rwkv_w2_b[d],
                         rwkv_a0_b[d], rwkv_a2_b[d], rwkv_k_k[d], rwkv_k_a[d], rwkv_r_k[d],
                         rwkv_g2[d], rwkv_gn_g[d], rwkv_gn_b[d], w_proj_a[d], w_proj_b[d], w_out[d],
                         norm2_g[d], ffn_w_gate[d], ffn_w_up[d], ffn_conv_w[d], ffn_conv_b[d],
                         ffn_w_down[d])
    return rms_norm(x, norm_f_g)
```

```cpp
#include <hip/hip_runtime.h>
#include <hip/hip_cooperative_groups.h>
#include <cstdio>
#include <cstdint>
namespace cg = cooperative_groups;
namespace pg8 {
#define PG8_LAS __attribute__((address_space(3)))
typedef unsigned short bf16_t;
typedef short bf16x8 __attribute__((ext_vector_type(8)));
typedef float f32x4 __attribute__((ext_vector_type(4)));
typedef unsigned u32x4 __attribute__((ext_vector_type(4)));
constexpr int BM = 256, BK = 64, HALF = 128, HTB = HALF * BK * 2  , STAGE_BYTES = 8 * HTB, NXCD = 8, WGM = 8;

__host__ __device__ __forceinline__ int lds_byte(int r, int c) { const int st = (r >> 4) * 2 + (c >> 5), rr = r & 15, cc = c & 31, ob = rr * 64 + cc * 2; return st * 1024 + (ob ^ (((ob >> 9) & 1) << 5)); }
__host__ __device__ __forceinline__ void stage_rc(int b, int& R, int& C) { const int st = b / 1024, sb = b % 1024, swz = sb ^ (((sb >> 9) & 1) << 5); R = (st >> 1) * 16 + swz / 64; C = (st & 1) * 32 + (swz % 64) / 2; }
__host__ __device__ __forceinline__ int perm32(int rho) { const int n = rho >> 4, i = rho & 15; return 8 * (i >> 2) + 4 * n + (i & 3); }

struct Unit { int pm, pn; };
struct Gemm { const bf16_t* A; const bf16_t* Bt; int M, N, K; };

struct StaticOrder {
    int nM, nN, nwg, G, c;
    __host__ __device__ void init(int M, int N, int G_, int c_) { nM = M / BM; nN = N / BM; nwg = nM * nN; G = G_; c = c_; }
    __host__ __device__ bool next(int i, Unit& u) const {
        const long L = (long)i * G + c; if (L >= nwg) return false;
        int wgid = (int)L; { const int q = nwg / NXCD, r = nwg % NXCD, xcd = wgid % NXCD, off = wgid / NXCD; wgid = (xcd < r ? xcd * (q + 1) : r * (q + 1) + (xcd - r) * q) + off; }
        const int nig = WGM * nN, gid = wgid / nig, fm = gid * WGM, gsz = (nM - fm) < WGM ? (nM - fm) : WGM;
        u.pm = fm + ((wgid % nig) % gsz); u.pn = (wgid % nig) / gsz; return true;
    }
    __device__ __forceinline__ void a_ready(const Unit&) const {}
    __device__ __forceinline__ void done(const Unit&) const {}
};

__device__ __forceinline__ unsigned cvt_pk_bf16(float lo, float hi) { unsigned r; asm volatile("v_cvt_pk_bf16_f32 %0, %1, %2" : "=v"(r) : "v"(lo), "v"(hi)); return r; }
typedef float f32x2 __attribute__((ext_vector_type(2)));
__device__ __forceinline__ f32x2 gelu_pk(f32x2 v) {
    const f32x2 av = __builtin_elementwise_abs(v), d = av * 0.2316418882f + 1.0f;
    f32x2 t; t.x = __builtin_amdgcn_rcpf(d.x); t.y = __builtin_amdgcn_rcpf(d.y);
    f32x2 q = t * 0.5307027145f + (-0.7265760135f); q = q * t + 0.7107068705f; q = q * t + (-0.142248368f); q = q * t + 0.127414796f; q = q * t;
    const f32x2 s = (v * v) * (-0.72134752044f);
    f32x2 e; e.x = __builtin_amdgcn_exp2f(s.x); e.y = __builtin_amdgcn_exp2f(s.y);
    const f32x2 m = v * (q * e), r = v - m;
    f32x2 o; o.x = v.x < 0.f ? m.x : r.x; o.y = v.y < 0.f ? m.y : r.y; return o;
}

template <class Epi, class Sched, bool ALIGN_EPI = false, bool SP2 = false>
__device__ __forceinline__ void gemm_phase(PG8_LAS unsigned char* lds, const Gemm g, const Sched& S, const Epi& E) {
    const int tid = threadIdx.x, wid = __builtin_amdgcn_readfirstlane(tid >> 6), lane = tid & 63, wr = wid >> 2, wc = wid & 3, fr = lane & 15, fq = lane >> 4;
    const int K = g.K, nt = K / BK;
    unsigned voffA[2], voffB[2];
#pragma unroll
    for (int i = 0; i < 2; ++i) { int R, C; stage_rc(tid * 16 + i * 8192, R, C); const int Rb = Epi::PERM ? ((R & ~31) + perm32(R & 31)) : R;
        voffA[i] = (unsigned)(R * K + C) * 2u; voffB[i] = (unsigned)(Rb * K + C) * 2u; }
    const size_t kstep = (size_t)(BK * 2);
    const size_t hstep = (size_t)HALF * K * 2;
    const size_t tstep = 2 * hstep;
    const unsigned ldsw = (unsigned)wid * 1024u;
    const int aoff = lds_byte(wr * 64 + fr, fq * 8), boff = lds_byte(wc * 32 + fr, fq * 8);
#define PG8_SA(b, h) (((b) * 2 + (h)) * HTB)
#define PG8_SB(b, h) ((4 + (b) * 2 + (h)) * HTB)
#define PG8_STAGE(bufoff, gbase, voff) do { _Pragma("unroll") for (int _i = 0; _i < 2; ++_i) \
        __builtin_amdgcn_global_load_lds((const unsigned*)((const char*)(gbase) + (voff)[_i]), (PG8_LAS unsigned*)(lds + (bufoff) + ldsw + _i * 8192), 16, 0, 0); } while (0)
#define PG8_LDA(dst, b, h) do { _Pragma("unroll") for (int m = 0; m < 4; ++m) _Pragma("unroll") for (int k = 0; k < 2; ++k) dst[m][k] = *(const PG8_LAS bf16x8*)(lds + PG8_SA(b, h) + aoff + m * 2048 + k * 1024); } while (0)
#define PG8_LDB(dst, b, h) do { _Pragma("unroll") for (int n = 0; n < 2; ++n) _Pragma("unroll") for (int k = 0; k < 2; ++k) dst[n][k] = *(const PG8_LAS bf16x8*)(lds + PG8_SB(b, h) + boff + n * 2048 + k * 1024); } while (0)
#define PG8_MMA(ai, bj, At, Bt) do { __builtin_amdgcn_s_setprio(1); _Pragma("unroll") for (int m = 0; m < 4; ++m) _Pragma("unroll") for (int n = 0; n < 2; ++n) _Pragma("unroll") for (int k = 0; k < 2; ++k) \
        acc[ai][bj][m][n] = __builtin_amdgcn_mfma_f32_16x16x32_bf16(Bt[n][k], At[m][k], acc[ai][bj][m][n], 0, 0, 0); __builtin_amdgcn_s_setprio(0); } while (0)
#define PG8_WAIT_V(n) asm volatile("s_waitcnt vmcnt(" #n ")" ::: "memory")
#define PG8_WAIT_L(n) asm volatile("s_waitcnt lgkmcnt(" #n ")" ::: "memory")
#define PG8_BAR __builtin_amdgcn_s_barrier()
#define PG8_SCHED __builtin_amdgcn_sched_barrier(0)
    Unit cur, nxt; int ui = 0;
    if (!S.next(0, cur)) return;
    f32x4 acc[2][2][4][2];
#pragma unroll
    for (int a = 0; a < 2; ++a)
#pragma unroll
        for (int b = 0; b < 2; ++b)
#pragma unroll
            for (int m = 0; m < 4; ++m)
#pragma unroll
                for (int n = 0; n < 2; ++n) acc[a][b][m][n] = (f32x4){0.f, 0.f, 0.f, 0.f};
    bf16x8 At[4][2], B0[2][2], B1[2][2];
    const char* cA = (const char*)g.A + (size_t)cur.pm * tstep; const char* cB = (const char*)g.Bt + (size_t)cur.pn * tstep;
    S.a_ready(cur);
    if constexpr (SP2) {
        PG8_STAGE(PG8_SB(0, 0), cB, voffB); PG8_STAGE(PG8_SB(0, 1), cB + hstep, voffB); PG8_STAGE(PG8_SA(0, 0), cA, voffA); PG8_STAGE(PG8_SA(0, 1), cA + hstep, voffA);
        if (wr == 1) PG8_BAR;
        PG8_WAIT_V(2); PG8_BAR;
        PG8_STAGE(PG8_SB(1, 0), cB + kstep, voffB); PG8_STAGE(PG8_SA(1, 0), cA + kstep, voffA); PG8_STAGE(PG8_SB(1, 1), cB + hstep + kstep, voffB);
        PG8_WAIT_V(6); PG8_BAR;
    } else {
        PG8_STAGE(PG8_SB(0, 0), cB, voffB); PG8_STAGE(PG8_SA(0, 0), cA, voffA); PG8_STAGE(PG8_SB(0, 1), cB + hstep, voffB); PG8_STAGE(PG8_SA(0, 1), cA + hstep, voffA);
        if (wr == 1) PG8_BAR;
        PG8_WAIT_V(4); PG8_BAR;
        PG8_STAGE(PG8_SB(1, 0), cB + kstep, voffB); PG8_STAGE(PG8_SA(1, 0), cA + kstep, voffA); PG8_STAGE(PG8_SB(1, 1), cB + hstep + kstep, voffB);
        PG8_WAIT_V(6); PG8_BAR;
    }
    for (;;) {
        const bool has_next = S.next(ui + 1, nxt);
        const char* nA = has_next ? (const char*)g.A + (size_t)nxt.pm * tstep : cA; const char* nB = has_next ? (const char*)g.Bt + (size_t)nxt.pn * tstep : cB;
        for (int t = 0; t < nt; t += 2) {
            const bool last = (t == nt - 2);
            const char* a1 = cA + (size_t)(t + 1) * kstep;
            const char* a2 = last ? nA : cA + (size_t)(t + 2) * kstep; const char* b2 = last ? nB : cB + (size_t)(t + 2) * kstep;
            const char* a3 = a2 + kstep; const char* b3 = b2 + kstep;
            if (last && has_next) S.a_ready(nxt);
            if constexpr (SP2) {
            PG8_LDB(B0, 0, 0); PG8_LDB(B1, 0, 1); PG8_SCHED; PG8_LDA(At, 0, 0); PG8_STAGE(PG8_SA(1, 1), a1 + hstep, voffA);
            PG8_WAIT_V(8); PG8_WAIT_L(0); PG8_BAR; PG8_MMA(0, 0, At, B0); PG8_MMA(0, 1, At, B1); PG8_BAR; PG8_SCHED;
            PG8_LDA(At, 0, 1); PG8_STAGE(PG8_SB(0, 0), b2, voffB); PG8_STAGE(PG8_SB(0, 1), b2 + hstep, voffB); PG8_STAGE(PG8_SA(0, 0), a2, voffA);
            PG8_WAIT_V(8); PG8_WAIT_L(0); PG8_BAR; PG8_MMA(1, 0, At, B0); PG8_MMA(1, 1, At, B1); PG8_BAR; PG8_SCHED;
            PG8_LDB(B0, 1, 0); PG8_LDB(B1, 1, 1); PG8_SCHED; PG8_LDA(At, 1, 0); PG8_STAGE(PG8_SA(0, 1), a2 + hstep, voffA);
            PG8_WAIT_V(8); PG8_WAIT_L(0); PG8_BAR; PG8_MMA(0, 0, At, B0); PG8_MMA(0, 1, At, B1); PG8_BAR; PG8_SCHED;
            PG8_LDA(At, 1, 1); PG8_STAGE(PG8_SB(1, 0), b3, voffB); PG8_STAGE(PG8_SB(1, 1), b3 + hstep, voffB); PG8_STAGE(PG8_SA(1, 0), a3, voffA);
            PG8_WAIT_V(8); PG8_WAIT_L(0); PG8_BAR; PG8_MMA(1, 0, At, B0); PG8_MMA(1, 1, At, B1); PG8_BAR; PG8_SCHED;
            } else {
            PG8_LDB(B0, 0, 0); PG8_SCHED; PG8_LDA(At, 0, 0); PG8_STAGE(PG8_SA(1, 1), a1 + hstep, voffA);
            PG8_WAIT_L(8); PG8_BAR; PG8_WAIT_L(0); PG8_MMA(0, 0, At, B0); PG8_BAR; PG8_SCHED;
            PG8_LDB(B1, 0, 1); PG8_STAGE(PG8_SB(0, 0), b2, voffB);
            PG8_BAR; PG8_WAIT_L(0); PG8_MMA(0, 1, At, B1); PG8_BAR;
            PG8_LDA(At, 0, 1); PG8_STAGE(PG8_SA(0, 0), a2, voffA);
            PG8_BAR; PG8_WAIT_L(0); PG8_MMA(1, 0, At, B0); PG8_BAR; PG8_SCHED;
            PG8_STAGE(PG8_SB(0, 1), b2 + hstep, voffB);
            PG8_WAIT_V(6); PG8_BAR; PG8_MMA(1, 1, At, B1); PG8_BAR;
            PG8_LDB(B0, 1, 0); PG8_SCHED; PG8_LDA(At, 1, 0); PG8_STAGE(PG8_SA(0, 1), a2 + hstep, voffA);
            PG8_WAIT_L(8); PG8_BAR; PG8_WAIT_L(0); PG8_MMA(0, 0, At, B0); PG8_BAR; PG8_SCHED;
            PG8_LDB(B1, 1, 1); PG8_STAGE(PG8_SB(1, 0), b3, voffB);
            PG8_BAR; PG8_WAIT_L(0); PG8_MMA(0, 1, At, B1); PG8_BAR;
            PG8_LDA(At, 1, 1); PG8_STAGE(PG8_SA(1, 0), a3, voffA);
            PG8_BAR; PG8_WAIT_L(0); PG8_MMA(1, 0, At, B0); PG8_BAR; PG8_SCHED;
            PG8_STAGE(PG8_SB(1, 1), b3 + hstep, voffB);
            PG8_WAIT_V(6); PG8_BAR; PG8_MMA(1, 1, At, B1); PG8_BAR;
            }
        }
        if constexpr (ALIGN_EPI) { if (wr == 0) PG8_BAR; }
        if constexpr (!Epi::AFTER_DRAIN) { E(acc, cur, wr, wc, fr, fq); S.done(cur); }
        if (!has_next) break;
#pragma unroll
        for (int a = 0; a < 2; ++a)
#pragma unroll
            for (int b = 0; b < 2; ++b)
#pragma unroll
                for (int m = 0; m < 4; ++m)
#pragma unroll
                    for (int n = 0; n < 2; ++n) acc[a][b][m][n] = (f32x4){0.f, 0.f, 0.f, 0.f};
        cur = nxt; cA = nA; cB = nB; ++ui;
        if constexpr (ALIGN_EPI) { if (wr == 1) PG8_BAR; }
    }
    PG8_WAIT_V(0);
    if constexpr (!ALIGN_EPI) { if (wr == 0) PG8_BAR; }
    PG8_BAR;
    if constexpr (Epi::AFTER_DRAIN) { E.fused(acc, cur, wr, wc, fr, fq, lds, wid, lane); S.done(cur); }
#undef PG8_SA
#undef PG8_SB
#undef PG8_STAGE
#undef PG8_LDA
#undef PG8_LDB
#undef PG8_MMA
#undef PG8_WAIT_V
#undef PG8_WAIT_L
#undef PG8_BAR
#undef PG8_SCHED
}
}

constexpr int NWAVES = 8, NTHR = 512;
constexpr int DM = 2048, SEQ = 4096, MTOK = 8192;
constexpr int SGW = 1024, RWW = 1024, NHEAD = 16, HDIM = 64;
constexpr int FEAT = 3488, FEATP = 3584, INW = 9632, INWP = 9728;
constexpr int DFF = 5632;
constexpr float NORM_EPS = 1e-6f, LN_EPS = 1e-5f, GN_EPS = 64e-5f;
#ifndef MK_SPLIT
#define MK_SPLIT 1
#endif
constexpr int NPHASE = 14;

constexpr size_t MiB = 1u << 20;
constexpr size_t WS_RSTD1 = 1 * MiB, WS_RSTD2 = 1 * MiB + 65536;
constexpr size_t WS_WPA = 2 * MiB, WS_WPB = 6 * MiB, WS_WOUT = 10 * MiB, WS_WG = 18 * MiB, WS_WU = 40 * MiB, WS_WD = 62 * MiB;
constexpr size_t WS_WIN = 84 * MiB, WS_XB = 122 * MiB;
constexpr size_t WS_MG = 154 * MiB, WS_SGB = 186 * MiB;
constexpr size_t WS_FEAT = 218 * MiB;
constexpr size_t WS_GG = 274 * MiB;
constexpr size_t WS_SR = 84 * MiB, WS_SK = 100 * MiB, WS_SV = 116 * MiB, WS_SKK = 132 * MiB;
constexpr size_t WS_OF = 218 * MiB, WS_OB = 234 * MiB, WS_YB = 250 * MiB;
constexpr size_t WS_X1B = 84 * MiB, WS_GT = 116 * MiB, WS_A3 = 204 * MiB;
constexpr size_t WS_END = 292 * MiB;
constexpr size_t DO_U = 0, DO_VG = 16 * MiB, DO_YA = 32 * MiB;
constexpr size_t DO_WF = 0, DO_AF = 16 * MiB, DO_WB = 32 * MiB, DO_AB = 48 * MiB;

constexpr int LDS_BYTES = 147456;

#define LAS __attribute__((address_space(3)))
typedef unsigned short bf16;
typedef unsigned v4u __attribute__((ext_vector_type(4)));
typedef unsigned v2u __attribute__((ext_vector_type(2)));
typedef float f32x4 __attribute__((ext_vector_type(4)));
#define LDS_WAIT() asm volatile("s_waitcnt lgkmcnt(0)" ::: "memory")
__device__ __forceinline__ unsigned f2bf(float f) { unsigned u = __float_as_uint(f); return (u + 0x7fffu + ((u >> 16) & 1u)) >> 16; }
__device__ __forceinline__ unsigned pk2(float lo, float hi) { return f2bf(lo) | (f2bf(hi) << 16); }
__device__ __forceinline__ float bf2f(unsigned b) { return __uint_as_float(b << 16); }
__device__ __forceinline__ float bflo(unsigned w) { return __uint_as_float(w << 16); }
__device__ __forceinline__ float bfhi(unsigned w) { return __uint_as_float(w & 0xffff0000u); }
__device__ __forceinline__ float sigmoidf_(float x) { return __builtin_amdgcn_rcpf(1.0f + __builtin_amdgcn_exp2f(-1.44269504089f * x)); }
__device__ __forceinline__ float wave_sum(float v) {
#pragma unroll
    for (int o = 1; o < 64; o <<= 1) v += __shfl_xor(v, o);
    return v;
}

namespace pg8 {
struct EpiIn {
    static constexpr bool PERM = true, AFTER_DRAIN = false;
    bf16_t *U, *VG, *FT, *SGA, *SGB; const float* rstd;
    __device__ __forceinline__ void operator()(const f32x4 (&acc)[2][2][4][2], const Unit& u, int wr, int wc, int fr, int fq) const {
        const int row0 = u.pm * BM + wr * 64 + fr; const int pn = u.pn;
        bf16_t* base; int ldc, colt, mode;
        if (pn < 4) { base = U; ldc = 1024; colt = pn * 256; mode = 0; }
        else if (pn < 8) { base = VG; ldc = 1024; colt = (pn - 4) * 256; mode = 0; }
        else if (pn < 22) { base = FT; ldc = FEATP; colt = (pn - 8) * 256; mode = 1; }
        else if (pn < 30) { base = SGA; ldc = 2048; colt = (pn - 22) * 256; mode = 2; }
        else { base = SGB; ldc = 2048; colt = (pn - 30) * 256; mode = 2; }
        const int col0 = colt + wc * 32 + 8 * fq;
#pragma unroll
        for (int ai = 0; ai < 2; ++ai)
#pragma unroll
            for (int m = 0; m < 4; ++m) { const int row = row0 + ai * HALF + m * 16; const float rs = rstd[row]; bf16_t* rowp = base + (size_t)row * ldc + col0;
#pragma unroll
                for (int bj = 0; bj < 2; ++bj) { f32x4 v0 = acc[ai][bj][m][0] * rs, v1 = acc[ai][bj][m][1] * rs;
                    if (mode == 0) { f32x2 a = gelu_pk((f32x2){v0[0], v0[1]}), b = gelu_pk((f32x2){v0[2], v0[3]}), c = gelu_pk((f32x2){v1[0], v1[1]}), d = gelu_pk((f32x2){v1[2], v1[3]});
                        v0 = (f32x4){a.x, a.y, b.x, b.y}; v1 = (f32x4){c.x, c.y, d.x, d.y}; }
                    else if (mode == 2) {
#pragma unroll
                        for (int j = 0; j < 4; ++j) { v0[j] = sigmoidf_(v0[j]); v1[j] = sigmoidf_(v1[j]); } }
                    u32x4 w; w.x = cvt_pk_bf16(v0[0], v0[1]); w.y = cvt_pk_bf16(v0[2], v0[3]); w.z = cvt_pk_bf16(v1[0], v1[1]); w.w = cvt_pk_bf16(v1[2], v1[3]);
                    *(u32x4*)(rowp + bj * HALF) = w; } }
    }
};
template <int SECOND> struct EpiProj {
    static constexpr bool PERM = true, AFTER_DRAIN = false;
    bf16_t* MG; const bf16_t* SGB;
    __device__ __forceinline__ void operator()(const f32x4 (&acc)[2][2][4][2], const Unit& u, int wr, int wc, int fr, int fq) const {
        const int row0 = u.pm * BM + wr * 64 + fr, col0 = u.pn * BM + wc * 32 + 8 * fq;
#pragma unroll
        for (int ai = 0; ai < 2; ++ai)
#pragma unroll
            for (int m = 0; m < 4; ++m) { const size_t off = (size_t)(row0 + ai * HALF + m * 16) * DM + col0;
#pragma unroll
                for (int bj = 0; bj < 2; ++bj) { const f32x4 a0 = acc[ai][bj][m][0], a1 = acc[ai][bj][m][1];
                    const u32x4 mg = *(const u32x4*)(MG + off + bj * HALF);
                    float o[8];
                    if (SECOND) { const u32x4 sg = *(const u32x4*)(SGB + off + bj * HALF);
                        o[0] = bflo(mg.x) + bflo(sg.x) * a0[0]; o[1] = bfhi(mg.x) + bfhi(sg.x) * a0[1]; o[2] = bflo(mg.y) + bflo(sg.y) * a0[2]; o[3] = bfhi(mg.y) + bfhi(sg.y) * a0[3];
                        o[4] = bflo(mg.z) + bflo(sg.z) * a1[0]; o[5] = bfhi(mg.z) + bfhi(sg.z) * a1[1]; o[6] = bflo(mg.w) + bflo(sg.w) * a1[2]; o[7] = bfhi(mg.w) + bfhi(sg.w) * a1[3]; }
                    else { o[0] = bflo(mg.x) * a0[0]; o[1] = bfhi(mg.x) * a0[1]; o[2] = bflo(mg.y) * a0[2]; o[3] = bfhi(mg.y) * a0[3];
                        o[4] = bflo(mg.z) * a1[0]; o[5] = bfhi(mg.z) * a1[1]; o[6] = bflo(mg.w) * a1[2]; o[7] = bfhi(mg.w) * a1[3]; }
                    u32x4 w; w.x = cvt_pk_bf16(o[0], o[1]); w.y = cvt_pk_bf16(o[2], o[3]); w.z = cvt_pk_bf16(o[4], o[5]); w.w = cvt_pk_bf16(o[6], o[7]);
                    *(u32x4*)(MG + off + bj * HALF) = w; } }
    }
};
struct EpiOut {
    static constexpr bool PERM = true, AFTER_DRAIN = false;
    const float* X; float* X1; bf16_t* X1B;
    __device__ __forceinline__ void operator()(const f32x4 (&acc)[2][2][4][2], const Unit& u, int wr, int wc, int fr, int fq) const {
        const int row0 = u.pm * BM + wr * 64 + fr, col0 = u.pn * BM + wc * 32 + 8 * fq;
#pragma unroll
        for (int ai = 0; ai < 2; ++ai)
#pragma unroll
            for (int m = 0; m < 4; ++m) { const size_t off = (size_t)(row0 + ai * HALF + m * 16) * DM + col0;
#pragma unroll
                for (int bj = 0; bj < 2; ++bj) { const f32x4 x0 = *(const f32x4*)(X + off + bj * HALF), x1 = *(const f32x4*)(X + off + bj * HALF + 4);
                    const f32x4 o0 = x0 + acc[ai][bj][m][0], o1 = x1 + acc[ai][bj][m][1];
                    *(f32x4*)(X1 + off + bj * HALF) = o0; *(f32x4*)(X1 + off + bj * HALF + 4) = o1;
                    u32x4 w; w.x = cvt_pk_bf16(o0[0], o0[1]); w.y = cvt_pk_bf16(o0[2], o0[3]); w.z = cvt_pk_bf16(o1[0], o1[1]); w.w = cvt_pk_bf16(o1[2], o1[3]);
                    *(u32x4*)(X1B + off + bj * HALF) = w; } }
    }
};
struct EpiGate {
    static constexpr bool PERM = true, AFTER_DRAIN = false;
    bf16_t* GT; const float* rstd;
    __device__ __forceinline__ void operator()(const f32x4 (&acc)[2][2][4][2], const Unit& u, int wr, int wc, int fr, int fq) const {
        const int row0 = u.pm * BM + wr * 64 + fr, col0 = u.pn * BM + wc * 32 + 8 * fq;
#pragma unroll
        for (int ai = 0; ai < 2; ++ai)
#pragma unroll
            for (int m = 0; m < 4; ++m) { const int row = row0 + ai * HALF + m * 16; const float rs = rstd[row]; bf16_t* rowp = GT + (size_t)row * DFF + col0;
#pragma unroll
                for (int bj = 0; bj < 2; ++bj) { const f32x4 v0 = acc[ai][bj][m][0] * rs, v1 = acc[ai][bj][m][1] * rs;
                    u32x4 w; w.x = cvt_pk_bf16(v0[0], v0[1]); w.y = cvt_pk_bf16(v0[2], v0[3]); w.z = cvt_pk_bf16(v1[0], v1[1]); w.w = cvt_pk_bf16(v1[2], v1[3]);
                    *(u32x4*)(rowp + bj * HALF) = w; } }
    }
};
struct EpiUp {
    static constexpr bool PERM = true, AFTER_DRAIN = false;
    const bf16_t* GT; bf16_t* A3; const float *rstd, *cw, *cb;
    __device__ __forceinline__ void operator()(const f32x4 (&acc)[2][2][4][2], const Unit& u, int wr, int wc, int fr, int fq) const {
        const int row0 = u.pm * BM + wr * 64 + fr, colb = u.pn * BM + wc * 32 + 8 * fq;
#pragma unroll
        for (int bj = 0; bj < 2; ++bj) { const int col = colb + bj * HALF;
            float w0[8], w1[8], w2[8], bb[8];
#pragma unroll
            for (int h = 0; h < 2; ++h) { const f32x4 a = *(const f32x4*)(cw + col + 4 * h), b = *(const f32x4*)(cw + DFF + col + 4 * h), c = *(const f32x4*)(cw + 2 * DFF + col + 4 * h), d = *(const f32x4*)(cb + col + 4 * h);
#pragma unroll
                for (int j = 0; j < 4; ++j) { w0[4 * h + j] = a[j]; w1[4 * h + j] = b[j]; w2[4 * h + j] = c[j]; bb[4 * h + j] = d[j]; } }
#pragma unroll
            for (int ai = 0; ai < 2; ++ai)
#pragma unroll
                for (int m = 0; m < 4; ++m) { const int row = row0 + ai * HALF + m * 16; const int t = row & (SEQ - 1); const float rs = rstd[row];
                    const bf16_t* gp = GT + (size_t)row * DFF + col;
                    const u32x4 gc = *(const u32x4*)gp; u32x4 gm = (u32x4){0u, 0u, 0u, 0u}, gx = (u32x4){0u, 0u, 0u, 0u};
                    if (t > 0) gm = *(const u32x4*)(gp - DFF);
                    if (t < SEQ - 1) gx = *(const u32x4*)(gp + DFF);
                    float o[8];
#pragma unroll
                    for (int e = 0; e < 8; ++e) { const unsigned cm = gm[e >> 1], cc = gc[e >> 1], cx = gx[e >> 1];
                        const float fm = (e & 1) ? bfhi(cm) : bflo(cm), fc = (e & 1) ? bfhi(cc) : bflo(cc), fx = (e & 1) ? bfhi(cx) : bflo(cx);
                        const float gt = w0[e] * fm + w1[e] * fc + w2[e] * fx + bb[e];
                        const float up = acc[ai][bj][m][e >> 2][e & 3] * rs;
                        o[e] = gt * sigmoidf_(gt) * up; }
                    u32x4 w; w.x = cvt_pk_bf16(o[0], o[1]); w.y = cvt_pk_bf16(o[2], o[3]); w.z = cvt_pk_bf16(o[4], o[5]); w.w = cvt_pk_bf16(o[6], o[7]);
                    *(u32x4*)(A3 + (size_t)row * DFF + col) = w; } }
    }
};
struct EpiDown {
    static constexpr bool PERM = true, AFTER_DRAIN = false;
    float* X1;
    __device__ __forceinline__ void operator()(const f32x4 (&acc)[2][2][4][2], const Unit& u, int wr, int wc, int fr, int fq) const {
        const int row0 = u.pm * BM + wr * 64 + fr, col0 = u.pn * BM + wc * 32 + 8 * fq;
#pragma unroll
        for (int ai = 0; ai < 2; ++ai)
#pragma unroll
            for (int m = 0; m < 4; ++m) { const size_t off = (size_t)(row0 + ai * HALF + m * 16) * DM + col0;
#pragma unroll
                for (int bj = 0; bj < 2; ++bj) { const f32x4 x0 = *(const f32x4*)(X1 + off + bj * HALF), x1 = *(const f32x4*)(X1 + off + bj * HALF + 4);
                    *(f32x4*)(X1 + off + bj * HALF) = x0 + acc[ai][bj][m][0]; *(f32x4*)(X1 + off + bj * HALF + 4) = x1 + acc[ai][bj][m][1]; } }
    }
};
}

struct Args { const float* in[33]; float* out; unsigned char* ws; int ph_lo, ph_hi; };
enum { I_X = 0, I_N1G, I_WIN, I_SLNG, I_SLNB, I_SW, I_SB, I_MUP, I_MUN, I_W0F, I_W2F, I_A0F, I_A2F, I_W0B, I_W2B, I_A0B, I_A2B, I_KK, I_KA, I_RK, I_G2, I_GNG, I_GNB,
       I_WPA, I_WPB, I_WOUT, I_N2G, I_WGATE, I_WUP, I_CW, I_CB, I_WDOWN, I_NFG };

__device__ __forceinline__ void p0_transpose_item(const float* W, int K, int N, bf16* WT, int drow0, const float* ksc, LAS float* scr, int k0, int n0, int lane) {
#pragma unroll 8
    for (int i = 0; i < 32; ++i) { const int kk = 2 * i + (lane >> 5); float v = W[(size_t)(k0 + kk) * N + n0 + (lane & 31)]; if (ksc) v *= ksc[k0 + kk]; scr[kk * 33 + (lane & 31)] = v; }
    LDS_WAIT(); asm volatile("" ::: "memory");
    const int c = lane & 7;
#pragma unroll
    for (int j = 0; j < 4; ++j) { const int n = (lane >> 3) + 8 * j; const LAS float* s = scr + (8 * c) * 33 + n;
        v4u o; o.x = pk2(s[0 * 33], s[1 * 33]); o.y = pk2(s[2 * 33], s[3 * 33]); o.z = pk2(s[4 * 33], s[5 * 33]); o.w = pk2(s[6 * 33], s[7 * 33]);
        *(v4u*)(WT + (size_t)(drow0 + n) * K + k0 + 8 * c) = o; }
    LDS_WAIT(); asm volatile("" ::: "memory");
}
__device__ __forceinline__ void phase_prologue(const Args& a, LAS unsigned char* lds, int G) {
    const int tid = threadIdx.x, lane = tid & 63, wave = tid >> 6;
    LAS float* scr = (LAS float*)(lds + wave * 16384);
    const int gw = blockIdx.x * NWAVES + wave, NGW = G * NWAVES;
    unsigned char* ws = a.ws;
    constexpr int I_IN = (DM / 64) * (INW / 32), I_PA = (SGW / 64) * (DM / 32), I_PB = I_PA, I_OUT = (DM / 64) * (DM / 32), I_G = (DM / 64) * (DFF / 32), I_U = I_G, I_D = (DFF / 64) * (DM / 32);
    constexpr int NITEMS = I_IN + I_PA + I_PB + I_OUT + I_G + I_U + I_D;
    for (int it = gw; it < NITEMS; it += NGW) {
        int r = it;
        if (r < I_IN) { const int nblk = INW / 32, kb = r / nblk, nb = r % nblk, n0 = 32 * nb; p0_transpose_item(a.in[I_WIN], DM, INW, (bf16*)(ws + WS_WIN), n0 < 5536 ? n0 : n0 + 96, a.in[I_N1G], scr, 64 * kb, n0, lane); continue; } r -= I_IN;
        if (r < I_PA) { const int nblk = DM / 32, kb = r / nblk, nb = r % nblk; p0_transpose_item(a.in[I_WPA], SGW, DM, (bf16*)(ws + WS_WPA), 32 * nb, nullptr, scr, 64 * kb, 32 * nb, lane); continue; } r -= I_PA;
        if (r < I_PB) { const int nblk = DM / 32, kb = r / nblk, nb = r % nblk; p0_transpose_item(a.in[I_WPB], RWW, DM, (bf16*)(ws + WS_WPB), 32 * nb, nullptr, scr, 64 * kb, 32 * nb, lane); continue; } r -= I_PB;
        if (r < I_OUT) { const int nblk = DM / 32, kb = r / nblk, nb = r % nblk; p0_transpose_item(a.in[I_WOUT], DM, DM, (bf16*)(ws + WS_WOUT), 32 * nb, nullptr, scr, 64 * kb, 32 * nb, lane); continue; } r -= I_OUT;
        if (r < I_G) { const int nblk = DFF / 32, kb = r / nblk, nb = r % nblk; p0_transpose_item(a.in[I_WGATE], DM, DFF, (bf16*)(ws + WS_WG), 32 * nb, a.in[I_N2G], scr, 64 * kb, 32 * nb, lane); continue; } r -= I_G;
        if (r < I_U) { const int nblk = DFF / 32, kb = r / nblk, nb = r % nblk; p0_transpose_item(a.in[I_WUP], DM, DFF, (bf16*)(ws + WS_WU), 32 * nb, a.in[I_N2G], scr, 64 * kb, 32 * nb, lane); continue; } r -= I_U;
        { const int nblk = DM / 32, kb = r / nblk, nb = r % nblk; p0_transpose_item(a.in[I_WDOWN], DFF, DM, (bf16*)(ws + WS_WD), 32 * nb, nullptr, scr, 64 * kb, 32 * nb, lane); }
    }
    { v4u* z = (v4u*)((bf16*)(ws + WS_WIN) + (size_t)5536 * DM); const int nz = 96 * DM * 2 / 16;
      for (int i = blockIdx.x * NTHR + tid; i < nz; i += G * NTHR) z[i] = (v4u){0u, 0u, 0u, 0u}; }
    const float* x = a.in[I_X]; bf16* xb = (bf16*)(ws + WS_XB); float* rstd1 = (float*)(ws + WS_RSTD1);
    for (int m = gw; m < MTOK; m += NGW) {
        const f32x4* xr = (const f32x4*)(x + (size_t)m * DM) + lane; f32x4 v[8]; float s = 0.f;
#pragma unroll
        for (int j = 0; j < 8; ++j) { v[j] = xr[64 * j]; s += (v[j].x * v[j].x + v[j].y * v[j].y) + (v[j].z * v[j].z + v[j].w * v[j].w); }
        s = wave_sum(s);
        if (lane == 0) rstd1[m] = 1.0f / sqrtf(s * (1.0f / DM) + NORM_EPS);
        unsigned long long* o8 = (unsigned long long*)(xb + (size_t)m * DM) + lane;
#pragma unroll
        for (int j = 0; j < 8; ++j) o8[64 * j] = (unsigned long long)pk2(v[j].x, v[j].y) | ((unsigned long long)pk2(v[j].z, v[j].w) << 32);
    }
}

__device__ __forceinline__ void phase_sgu(const Args& a, LAS unsigned char* lds, int G) {
    const int tid = threadIdx.x, lane = tid & 63, wave = tid >> 6;
    LAS float* wt = (LAS float*)lds;
    LAS float* vln = (LAS float*)(lds + 65536);
    LAS float* mu = (LAS float*)(lds + 131072);
    LAS float* rs = mu + 128;
    const bf16* U = (const bf16*)((unsigned char*)a.out + DO_U); const bf16* VG = (const bf16*)((unsigned char*)a.out + DO_VG); bf16* YA = (bf16*)((unsigned char*)a.out + DO_YA);
    const float* lng = a.in[I_SLNG]; const float* lnb = a.in[I_SLNB]; const float* sw = a.in[I_SW]; const float* sb = a.in[I_SB];
    for (int item = blockIdx.x; item < 512; item += G) {
        const int bc = item >> 3, g = item & 7, m0 = bc * 128;
        for (int rr = 0; rr < 16; ++rr) { const int r = wave * 16 + rr;
            const v4u* p = (const v4u*)(VG + (size_t)(m0 + r) * SGW + lane * 16); const v4u q0 = p[0], q1 = p[1];
            float f[16];
#pragma unroll
            for (int e = 0; e < 4; ++e) { f[2 * e] = bflo(q0[e]); f[2 * e + 1] = bfhi(q0[e]); f[8 + 2 * e] = bflo(q1[e]); f[8 + 2 * e + 1] = bfhi(q1[e]); }
            float s = 0.f;
#pragma unroll
            for (int e = 0; e < 16; ++e) s += f[e];
            const float mean = wave_sum(s) * (1.0f / SGW); float s2 = 0.f;
#pragma unroll
            for (int e = 0; e < 16; ++e) { const float d = f[e] - mean; s2 += d * d; }
            const float var = wave_sum(s2) * (1.0f / SGW);
            if (lane == 0) { mu[r] = mean; rs[r] = 1.0f / sqrtf(var + LN_EPS); } }
        for (int idx = tid; idx < 16384; idx += NTHR) { const int i = idx >> 7, j = idx & 127; wt[j * 128 + i] = sw[(size_t)g * 16384 + idx]; }
        __syncthreads();
        for (int idx = tid; idx < 16384; idx += NTHR) { const int j = idx >> 7, d = idx & 127; const int ch = g * 128 + d;
            vln[idx] = (bf2f(VG[(size_t)(m0 + j) * SGW + ch]) - mu[j]) * rs[j] * lng[ch] + lnb[ch]; }
        __syncthreads();
        const int d = tid & 127, ib = (tid >> 7) * 32;
        float acc[32];
#pragma unroll
        for (int i = 0; i < 32; ++i) acc[i] = 0.f;
        for (int j = 0; j < 128; ++j) { const float v = vln[j * 128 + d];
#pragma unroll
            for (int i4 = 0; i4 < 8; ++i4) { const f32x4 w4 = *(const LAS f32x4*)(wt + j * 128 + ib + 4 * i4);
                acc[4 * i4 + 0] += w4.x * v; acc[4 * i4 + 1] += w4.y * v; acc[4 * i4 + 2] += w4.z * v; acc[4 * i4 + 3] += w4.w * v; } }
#pragma unroll
        for (int ii = 0; ii < 32; ++ii) { const int i = ib + ii; const size_t off = (size_t)(m0 + i) * SGW + g * 128 + d;
            const float mixed = acc[ii] + sb[g * 128 + i];
            YA[off] = (bf16)f2bf(bf2f(U[off]) * mixed); }
        __syncthreads();
    }
}

constexpr int PT = 16;
__device__ __forceinline__ float softplusf_(float x) { return fmaxf(x, 0.f) + log1pf(expf(-fabsf(x))); }
__device__ __forceinline__ void phase_prep(const Args& a, LAS unsigned char* lds, int G) {
    const int tid = threadIdx.x;
    LAS float* act = (LAS float*)lds;
    unsigned char* ws = a.ws;
    const bf16* FT = (const bf16*)(ws + WS_FEAT);
    bf16 *SR = (bf16*)(ws + WS_SR), *SK = (bf16*)(ws + WS_SK), *SV = (bf16*)(ws + WS_SV), *SKK = (bf16*)(ws + WS_SKK), *GG = (bf16*)(ws + WS_GG);
    bf16 *WF = (bf16*)((unsigned char*)a.out + DO_WF), *AF = (bf16*)((unsigned char*)a.out + DO_AF), *WB = (bf16*)((unsigned char*)a.out + DO_WB), *AB = (bf16*)((unsigned char*)a.out + DO_AB);
    const float *mup = a.in[I_MUP], *mun = a.in[I_MUN];
    for (int tile = blockIdx.x; tile < MTOK / PT; tile += G) {
        const int m0 = tile * PT;
        for (int idx = tid; idx < 416 * PT; idx += NTHR) { const int t = idx / 416, j = idx - t * 416; const int m = m0 + t, ts = m & (SEQ - 1), col = 3072 + j;
            const float f = bf2f(FT[(size_t)m * FEATP + col]);
            const float fp = ts > 0 ? bf2f(FT[(size_t)(m - 1) * FEATP + col]) : 0.f, fn = ts < SEQ - 1 ? bf2f(FT[(size_t)(m + 1) * FEATP + col]) : 0.f;
            float xs = f + mup[col] * (fp - f) + mun[col] * (fn - f);
            if (j < 128) xs = tanhf(xs); else if (j >= 256) xs = sigmoidf_(xs);
            act[j * PT + t] = xs; }
        __syncthreads();
#pragma unroll 1
        for (int p = 0; p < 2; ++p) {
            const int c = tid + NTHR * p;
            float awf[PT], awb[PT], aaf[PT], aab[PT], ag[PT];
#pragma unroll
            for (int t = 0; t < PT; ++t) { awf[t] = 0.f; awb[t] = 0.f; aaf[t] = 0.f; aab[t] = 0.f; ag[t] = 0.f; }
#define LORA_ACC(ACC, WPTR, J0, NJ) for (int j = 0; j < (NJ); ++j) { const float wv = (WPTR)[(size_t)j * RWW + c]; \
            _Pragma("unroll") for (int t4 = 0; t4 < PT / 4; ++t4) { const f32x4 a4 = *(const LAS f32x4*)(act + ((J0) + j) * PT + 4 * t4); \
                ACC[4 * t4 + 0] += a4.x * wv; ACC[4 * t4 + 1] += a4.y * wv; ACC[4 * t4 + 2] += a4.z * wv; ACC[4 * t4 + 3] += a4.w * wv; } }
            LORA_ACC(awf, a.in[I_W2F], 0, 64)
            LORA_ACC(awb, a.in[I_W2B], 64, 64)
            LORA_ACC(aaf, a.in[I_A2F], 128, 64)
            LORA_ACC(aab, a.in[I_A2B], 192, 64)
            LORA_ACC(ag, a.in[I_G2], 256, 160)
#undef LORA_ACC
            const float w0f = a.in[I_W0F][c], w0b = a.in[I_W0B][c], a0f = a.in[I_A0F][c], a0b = a.in[I_A0B][c], kkc = a.in[I_KK][c];
            const float mpr = mup[c], mnr = mun[c], mpk = mup[1024 + c], mnk = mun[1024 + c], mpv = mup[2048 + c], mnv = mun[2048 + c];
            const int ts0 = m0 & (SEQ - 1);
            float rp, kp, vp, rc, kc, vc, rn, kn, vn;
            if (ts0 > 0) { const bf16* q = FT + (size_t)(m0 - 1) * FEATP + c; rp = bf2f(q[0]); kp = bf2f(q[1024]); vp = bf2f(q[2048]); } else { rp = 0.f; kp = 0.f; vp = 0.f; }
            { const bf16* q = FT + (size_t)m0 * FEATP + c; rc = bf2f(q[0]); kc = bf2f(q[1024]); vc = bf2f(q[2048]); }
#pragma unroll
            for (int t = 0; t < PT; ++t) { const int m = m0 + t;
                if (ts0 + t < SEQ - 1) { const bf16* q = FT + (size_t)(m + 1) * FEATP + c; rn = bf2f(q[0]); kn = bf2f(q[1024]); vn = bf2f(q[2048]); } else { rn = 0.f; kn = 0.f; vn = 0.f; }
                const float xr = rc + mpr * (rp - rc) + mnr * (rn - rc), xk = kc + mpk * (kp - kc) + mnk * (kn - kc), xv = vc + mpv * (vp - vc) + mnv * (vn - vc);
                const float k2 = xk * kkc; const float ss = wave_sum(k2 * k2); const float kkv = k2 * (1.0f / sqrtf(fmaxf(ss, 1e-24f)));
                const float ef = expf(-softplusf_(-(w0f + awf[t])) - 0.5f), eb = expf(-softplusf_(-(w0b + awb[t])) - 0.5f);
                const float omwf = 1.0f - expf(-ef), omwb = 1.0f - expf(-eb);
                const float af = sigmoidf_(a0f + aaf[t]), ab = sigmoidf_(a0b + aab[t]);
                const size_t o = (size_t)m * RWW + c;
                SR[o] = (bf16)f2bf(xr); SK[o] = (bf16)f2bf(xk); SV[o] = (bf16)f2bf(xv); SKK[o] = (bf16)f2bf(kkv);
                WF[o] = (bf16)f2bf(omwf); AF[o] = (bf16)f2bf(af); WB[o] = (bf16)f2bf(omwb); AB[o] = (bf16)f2bf(ab); GG[o] = (bf16)f2bf(ag[t]);
                rp = rc; kp = kc; vp = vc; rc = rn; kc = kn; vc = vn; }
        }
        __syncthreads();
    }
}

template <int CTRL> __device__ __forceinline__ float dpp_f(float x) { return __int_as_float(__builtin_amdgcn_update_dpp(0, __float_as_int(x), CTRL, 0xF, 0xF, true)); }
__device__ __forceinline__ float allreduce16(float x) { x += dpp_f<0xB1>(x); x += dpp_f<0x4E>(x); x += dpp_f<0x141>(x); x += dpp_f<0x140>(x); return x; }
constexpr int SCH = 16, SROW = 336;
__device__ __forceinline__ void phase_scan(const Args& a, LAS unsigned char* lds, int G) {
    const int tid = threadIdx.x, lane = tid & 63, wave = __builtin_amdgcn_readfirstlane(tid >> 6);
    LAS float* buf = (LAS float*)lds;
    unsigned char* ws = a.ws;
    const bf16 *SR = (const bf16*)(ws + WS_SR), *SK = (const bf16*)(ws + WS_SK), *SV = (const bf16*)(ws + WS_SV), *SKK = (const bf16*)(ws + WS_SKK);
    const float* kap = a.in[I_KA];
    constexpr int NCH = SEQ / SCH;
    for (int item = blockIdx.x; item < 256; item += G) {
        const int sid = item >> 2, q = item & 3, dir = sid & 1, h = (sid >> 1) & 15, b = sid >> 5;
        const bf16* OMW = (const bf16*)((unsigned char*)a.out + (dir ? DO_WB : DO_WF)); const bf16* AA = (const bf16*)((unsigned char*)a.out + (dir ? DO_AB : DO_AF));
        bf16* OO = (bf16*)(ws + (dir ? WS_OB : WS_OF));
        if (wave >= 4) {
            const int lt = tid - 256, s = lt >> 4, ch4 = (lt & 15) * 4;
            const f32x4 ka4 = *(const f32x4*)(kap + h * 64 + ch4);
            v2u rr, rk, rv, rkk, rw, ra;
#define SCAN_LOAD(c) do { const int st = (c) * SCH + s; const int t = dir ? (SEQ - 1 - st) : st; const size_t o = ((size_t)(b * SEQ + t)) * RWW + h * 64 + ch4; \
            rr = *(const v2u*)(SR + o); rk = *(const v2u*)(SK + o); rv = *(const v2u*)(SV + o); rkk = *(const v2u*)(SKK + o); rw = *(const v2u*)(OMW + o); ra = *(const v2u*)(AA + o); } while (0)
#define SCAN_WRITE(c) do { LAS float* rec = buf + (((c) & 1) * SCH + s) * SROW; \
            f32x4 fr_ = (f32x4){bflo(rr.x), bfhi(rr.x), bflo(rr.y), bfhi(rr.y)}, fk = (f32x4){bflo(rk.x), bfhi(rk.x), bflo(rk.y), bfhi(rk.y)}, fv = (f32x4){bflo(rv.x), bfhi(rv.x), bflo(rv.y), bfhi(rv.y)}; \
            f32x4 fkk = (f32x4){bflo(rkk.x), bfhi(rkk.x), bflo(rkk.y), bfhi(rkk.y)}, fw = (f32x4){bflo(rw.x), bfhi(rw.x), bflo(rw.y), bfhi(rw.y)}, fa = (f32x4){bflo(ra.x), bfhi(ra.x), bflo(ra.y), bfhi(ra.y)}; \
            *(LAS f32x4*)(rec + ch4) = fkk; *(LAS f32x4*)(rec + 64 + ch4) = 1.0f - fw; *(LAS f32x4*)(rec + 128 + ch4) = fkk * fa; \
            *(LAS f32x4*)(rec + 192 + ch4) = fk * (1.0f + (fa - 1.0f) * ka4); *(LAS f32x4*)(rec + 256 + ch4) = fr_; \
            if ((ch4 >> 4) == q) *(LAS f32x4*)(rec + 320 + (ch4 & 15)) = fv; } while (0)
            SCAN_LOAD(0); SCAN_WRITE(0); SCAN_LOAD(1);
            __syncthreads();
            for (int c = 0; c < NCH; ++c) {
                if (c + 1 < NCH) SCAN_WRITE(c + 1);
                if (c + 2 < NCH) SCAN_LOAD(c + 2);
                __syncthreads();
            }
#undef SCAN_LOAD
#undef SCAN_WRITE
        } else {
            const int rg = lane >> 4, cq = lane & 15, vl = 4 * wave + rg;
            float S0 = 0.f, S1 = 0.f, S2 = 0.f, S3 = 0.f;
            bf16* op = OO + (size_t)b * SEQ * RWW + h * 64 + 16 * q + vl;
            __syncthreads();
            for (int c = 0; c < NCH; ++c) {
                const LAS float* cb = buf + (c & 1) * SCH * SROW;
#pragma unroll
                for (int s = 0; s < SCH; ++s) { const LAS float* rec = cb + s * SROW;
                    const f32x4 kk4 = *(const LAS f32x4*)(rec + 4 * cq), w4 = *(const LAS f32x4*)(rec + 64 + 4 * cq), b4 = *(const LAS f32x4*)(rec + 128 + 4 * cq);
                    const f32x4 kd4 = *(const LAS f32x4*)(rec + 192 + 4 * cq), r4 = *(const LAS f32x4*)(rec + 256 + 4 * cq); const float vv = rec[320 + vl];
                    float p = (S0 * kk4.x + S1 * kk4.y) + (S2 * kk4.z + S3 * kk4.w);
                    p = allreduce16(p);
                    S0 = S0 * w4.x + vv * kd4.x; S1 = S1 * w4.y + vv * kd4.y; S2 = S2 * w4.z + vv * kd4.z; S3 = S3 * w4.w + vv * kd4.w;
                    S0 -= p * b4.x; S1 -= p * b4.y; S2 -= p * b4.z; S3 -= p * b4.w;
                    float o = (S0 * r4.x + S1 * r4.y) + (S2 * r4.z + S3 * r4.w);
                    o = allreduce16(o);
                    const int st = c * SCH + s; const int t = dir ? (SEQ - 1 - st) : st;
                    if (cq == 0) op[(size_t)t * RWW] = (bf16)f2bf(o); }
                __syncthreads();
            }
        }
    }
}

__device__ __forceinline__ void phase_post(const Args& a, int G) {
    const int tid = threadIdx.x;
    unsigned char* ws = a.ws;
    const bf16 *SR = (const bf16*)(ws + WS_SR), *SK = (const bf16*)(ws + WS_SK), *SV = (const bf16*)(ws + WS_SV), *GG = (const bf16*)(ws + WS_GG);
    const bf16 *AF = (const bf16*)((unsigned char*)a.out + DO_AF), *AB = (const bf16*)((unsigned char*)a.out + DO_AB);
    const bf16 *OF = (const bf16*)(ws + WS_OF), *OB = (const bf16*)(ws + WS_OB); bf16* YB = (bf16*)(ws + WS_YB);
    for (int p = 0; p < 2; ++p) { const int c = tid + NTHR * p;
        const float gng = a.in[I_GNG][c], gnb = a.in[I_GNB][c], ka = a.in[I_KA][c], rk = a.in[I_RK][c];
        for (int m = blockIdx.x; m < MTOK; m += G) { const size_t o = (size_t)m * RWW + c;
            const float ov = bf2f(OF[o]) + bf2f(OB[o]);
            const float mean = wave_sum(ov) * (1.0f / 64.0f); const float dv = ov - mean; const float var = wave_sum(dv * dv) * (1.0f / 64.0f);
            const float y = dv * (1.0f / sqrtf(var + GN_EPS)) * gng + gnb;
            const float r = bf2f(SR[o]), k = bf2f(SK[o]), v = bf2f(SV[o]), af = bf2f(AF[o]), ab = bf2f(AB[o]), g = bf2f(GG[o]);
            const float kfb = k * (2.0f + (af + ab - 2.0f) * ka);
            const float bs = wave_sum(r * kfb * rk);
            YB[o] = (bf16)f2bf((y + bs * v) * g); } }
}

__device__ __forceinline__ void phase_rstd2(const Args& a, int G) {
    const int tid = threadIdx.x, lane = tid & 63, wave = tid >> 6; const int gw = blockIdx.x * NWAVES + wave, NGW = G * NWAVES;
    float* rstd2 = (float*)(a.ws + WS_RSTD2);
    for (int m = gw; m < MTOK; m += NGW) { const f32x4* xr = (const f32x4*)(a.out + (size_t)m * DM) + lane; float s = 0.f;
#pragma unroll
        for (int j = 0; j < 8; ++j) { const f32x4 v = xr[64 * j]; s += (v.x * v.x + v.y * v.y) + (v.z * v.z + v.w * v.w); }
        s = wave_sum(s); if (lane == 0) rstd2[m] = 1.0f / sqrtf(s * (1.0f / DM) + NORM_EPS); }
}
__device__ __forceinline__ void phase_final(const Args& a, int G) {
    const int tid = threadIdx.x, lane = tid & 63, wave = tid >> 6; const int gw = blockIdx.x * NWAVES + wave, NGW = G * NWAVES;
    const f32x4* gf = (const f32x4*)a.in[I_NFG] + lane;
    for (int m = gw; m < MTOK; m += NGW) { f32x4* xr = (f32x4*)(a.out + (size_t)m * DM) + lane; f32x4 v[8]; float s = 0.f;
#pragma unroll
        for (int j = 0; j < 8; ++j) { v[j] = xr[64 * j]; s += (v[j].x * v[j].x + v[j].y * v[j].y) + (v[j].z * v[j].z + v[j].w * v[j].w); }
        const float rs = 1.0f / sqrtf(wave_sum(s) * (1.0f / DM) + NORM_EPS);
#pragma unroll
        for (int j = 0; j < 8; ++j) xr[64 * j] = v[j] * rs * gf[64 * j]; }
}

__global__ void __launch_bounds__(NTHR, 2) fwd_kernel(Args a) {
    extern __shared__ __attribute__((aligned(16))) unsigned char lds_raw[];
    LAS unsigned char* lds = (LAS unsigned char*)lds_raw;
    const int G = gridDim.x, lo = a.ph_lo, hi = a.ph_hi;
    unsigned char* ws = a.ws;
#define IN(k) (lo <= (k) && (k) < hi)
#define SEAM(k) do { if (IN(k) && IN((k) + 1)) { cg::this_grid().sync(); } } while (0)
    typedef pg8::bf16_t B;
    if (IN(0)) { phase_prologue(a, lds, G); } SEAM(0);
    if (IN(1)) { pg8::Gemm g{(const B*)(ws + WS_XB), (const B*)(ws + WS_WIN), MTOK, INWP, DM}; pg8::StaticOrder S; S.init(MTOK, INWP, G, (int)blockIdx.x);
        pg8::EpiIn E{(B*)((unsigned char*)a.out + DO_U), (B*)((unsigned char*)a.out + DO_VG), (B*)(ws + WS_FEAT), (B*)(ws + WS_MG), (B*)(ws + WS_SGB), (const float*)(ws + WS_RSTD1)};
        pg8::gemm_phase<pg8::EpiIn, pg8::StaticOrder, true, true>(lds, g, S, E); } SEAM(1);
    if (IN(2)) { phase_sgu(a, lds, G); } SEAM(2);
    if (IN(3)) { pg8::Gemm g{(const B*)((unsigned char*)a.out + DO_YA), (const B*)(ws + WS_WPA), MTOK, DM, SGW}; pg8::StaticOrder S; S.init(MTOK, DM, G, (int)blockIdx.x);
        pg8::EpiProj<0> E{(B*)(ws + WS_MG), nullptr};
        pg8::gemm_phase<pg8::EpiProj<0>, pg8::StaticOrder, true, true>(lds, g, S, E); } SEAM(3);
    if (IN(4)) { phase_prep(a, lds, G); } SEAM(4);
    if (IN(5)) { phase_scan(a, lds, G); } SEAM(5);
    if (IN(6)) { phase_post(a, G); } SEAM(6);
    if (IN(7)) { pg8::Gemm g{(const B*)(ws + WS_YB), (const B*)(ws + WS_WPB), MTOK, DM, RWW}; pg8::StaticOrder S; S.init(MTOK, DM, G, (int)blockIdx.x);
        pg8::EpiProj<1> E{(B*)(ws + WS_MG), (const B*)(ws + WS_SGB)};
        pg8::gemm_phase<pg8::EpiProj<1>, pg8::StaticOrder, true, true>(lds, g, S, E); } SEAM(7);
    if (IN(8)) { pg8::Gemm g{(const B*)(ws + WS_MG), (const B*)(ws + WS_WOUT), MTOK, DM, DM}; pg8::StaticOrder S; S.init(MTOK, DM, G, (int)blockIdx.x);
        pg8::EpiOut E{a.in[I_X], a.out, (B*)(ws + WS_X1B)};
        pg8::gemm_phase<pg8::EpiOut, pg8::StaticOrder, true, true>(lds, g, S, E); } SEAM(8);
    if (IN(9)) { phase_rstd2(a, G); } SEAM(9);
    if (IN(10)) { pg8::Gemm g{(const B*)(ws + WS_X1B), (const B*)(ws + WS_WG), MTOK, DFF, DM}; pg8::StaticOrder S; S.init(MTOK, DFF, G, (int)blockIdx.x);
        pg8::EpiGate E{(B*)(ws + WS_GT), (const float*)(ws + WS_RSTD2)};
        pg8::gemm_phase<pg8::EpiGate, pg8::StaticOrder, true, true>(lds, g, S, E); } SEAM(10);
    if (IN(11)) { pg8::Gemm g{(const B*)(ws + WS_X1B), (const B*)(ws + WS_WU), MTOK, DFF, DM}; pg8::StaticOrder S; S.init(MTOK, DFF, G, (int)blockIdx.x);
        pg8::EpiUp E{(const B*)(ws + WS_GT), (B*)(ws + WS_A3), (const float*)(ws + WS_RSTD2), a.in[I_CW], a.in[I_CB]};
        pg8::gemm_phase<pg8::EpiUp, pg8::StaticOrder, true, true>(lds, g, S, E); } SEAM(11);
    if (IN(12)) { pg8::Gemm g{(const B*)(ws + WS_A3), (const B*)(ws + WS_WD), MTOK, DM, DFF}; pg8::StaticOrder S; S.init(MTOK, DM, G, (int)blockIdx.x);
        pg8::EpiDown E{a.out};
        pg8::gemm_phase<pg8::EpiDown, pg8::StaticOrder, true, true>(lds, g, S, E); } SEAM(12);
    if (IN(13)) { phase_final(a, G); }
#undef IN
#undef SEAM
}

extern "C" void kernel_launch(void* const* d_in, const int* in_sizes, int n_in, void* d_out, int out_size, void* d_ws, size_t ws_size, hipStream_t stream) {
    static int grid = 0;
    if (grid == 0) {
        if (n_in != 33 || out_size != MTOK * DM || ws_size < WS_END) { fprintf(stderr, "kernel_launch: unexpected shapes (n_in %d, out %d, ws %zu); nothing launched\n", n_in, out_size, ws_size); grid = -1; return; }
        int dev = 0, cus = 0, per_cu = 0;
        if (hipGetDevice(&dev) != hipSuccess || hipDeviceGetAttribute(&cus, hipDeviceAttributeMultiprocessorCount, dev) != hipSuccess) { grid = -1; return; }
        if (hipFuncSetAttribute((const void*)fwd_kernel, hipFuncAttributeMaxDynamicSharedMemorySize, LDS_BYTES) != hipSuccess) { fprintf(stderr, "kernel_launch: hipFuncSetAttribute failed\n"); grid = -1; return; }
        if (hipOccupancyMaxActiveBlocksPerMultiprocessor(&per_cu, (const void*)fwd_kernel, NTHR, LDS_BYTES) != hipSuccess || per_cu < 1) { fprintf(stderr, "kernel_launch: occupancy query says %d blocks per CU\n", per_cu); (void)hipGetLastError(); per_cu = 1; }
        grid = cus;
    }
    if (grid < 0) return;
    Args a{};
    for (int i = 0; i < 33; ++i) a.in[i] = (const float*)d_in[i];
    a.out = (float*)d_out; a.ws = (unsigned char*)d_ws;
#if MK_SPLIT
    for (int p = 0; p < NPHASE; ++p) { a.ph_lo = p; a.ph_hi = p + 1; void* args[] = {&a};
        hipError_t e = hipLaunchCooperativeKernel((const void*)fwd_kernel, dim3(grid), dim3(NTHR), args, LDS_BYTES, stream);
        if (e != hipSuccess) { fprintf(stderr, "kernel_launch: launch of phase %d failed: %s\n", p, hipGetErrorString(e)); break; } }
#else
    a.ph_lo = 0; a.ph_hi = NPHASE; void* args[] = {&a};
    hipError_t e = hipLaunchCooperativeKernel((const void*)fwd_kernel, dim3(grid), dim3(NTHR), args, LDS_BYTES, stream);
    if (e != hipSuccess) fprintf(stderr, "kernel_launch: cooperative launch failed: %s (grid %d)\n", hipGetErrorString(e), grid);
#endif
}
```

```cpp
#include <hip/hip_runtime.h>
#include <hip/hip_cooperative_groups.h>
#include <cstdio>
#include <cstdint>
namespace cg = cooperative_groups;
namespace pg8 {
#define PG8_LAS __attribute__((address_space(3)))
typedef unsigned short bf16_t;
typedef short bf16x8 __attribute__((ext_vector_type(8)));
typedef float f32x4 __attribute__((ext_vector_type(4)));
typedef unsigned u32x4 __attribute__((ext_vector_type(4)));
constexpr int BM = 256, BK = 64, HALF = 128, HTB = HALF * BK * 2  , STAGE_BYTES = 8 * HTB, NXCD = 8, WGM = 8;

__host__ __device__ __forceinline__ int lds_byte(int r, int c) { const int st = (r >> 4) * 2 + (c >> 5), rr = r & 15, cc = c & 31, ob = rr * 64 + cc * 2; return st * 1024 + (ob ^ (((ob >> 9) & 1) << 5)); }
__host__ __device__ __forceinline__ void stage_rc(int b, int& R, int& C) { const int st = b / 1024, sb = b % 1024, swz = sb ^ (((sb >> 9) & 1) << 5); R = (st >> 1) * 16 + swz / 64; C = (st & 1) * 32 + (swz % 64) / 2; }
__host__ __device__ __forceinline__ int perm32(int rho) { const int n = rho >> 4, i = rho & 15; return 8 * (i >> 2) + 4 * n + (i & 3); }

struct Unit { int pm, pn; };
struct Gemm { const bf16_t* A; const bf16_t* Bt; int M, N, K; };

struct StaticOrder {
    int nM, nN, nwg, G, c;
    __host__ __device__ void init(int M, int N, int G_, int c_) { nM = M / BM; nN = N / BM; nwg = nM * nN; G = G_; c = c_; }
    __host__ __device__ bool next(int i, Unit& u) const {
        const long L = (long)i * G + c; if (L >= nwg) return false;
        int wgid = (int)L; { const int q = nwg / NXCD, r = nwg % NXCD, xcd = wgid % NXCD, off = wgid / NXCD; wgid = (xcd < r ? xcd * (q + 1) : r * (q + 1) + (xcd - r) * q) + off; }
        const int nig = WGM * nN, gid = wgid / nig, fm = gid * WGM, gsz = (nM - fm) < WGM ? (nM - fm) : WGM;
        u.pm = fm + ((wgid % nig) % gsz); u.pn = (wgid % nig) / gsz; return true;
    }
    __device__ __forceinline__ void a_ready(const Unit&) const {}
    __device__ __forceinline__ void done(const Unit&) const {}
};

__device__ __forceinline__ unsigned cvt_pk_bf16(float lo, float hi) { unsigned r; asm volatile("v_cvt_pk_bf16_f32 %0, %1, %2" : "=v"(r) : "v"(lo), "v"(hi)); return r; }
typedef float f32x2 __attribute__((ext_vector_type(2)));
__device__ __forceinline__ f32x2 gelu_pk(f32x2 v) {
    const f32x2 av = __builtin_elementwise_abs(v), d = av * 0.2316418882f + 1.0f;
    f32x2 t; t.x = __builtin_amdgcn_rcpf(d.x); t.y = __builtin_amdgcn_rcpf(d.y);
    f32x2 q = t * 0.5307027145f + (-0.7265760135f); q = q * t + 0.7107068705f; q = q * t + (-0.142248368f); q = q * t + 0.127414796f; q = q * t;
    const f32x2 s = (v * v) * (-0.72134752044f);
    f32x2 e; e.x = __builtin_amdgcn_exp2f(s.x); e.y = __builtin_amdgcn_exp2f(s.y);
    const f32x2 m = v * (q * e), r = v - m;
    f32x2 o; o.x = v.x < 0.f ? m.x : r.x; o.y = v.y < 0.f ? m.y : r.y; return o;
}

template <class Epi, class Sched, bool ALIGN_EPI = false, bool SP2 = false>
__device__ __forceinline__ void gemm_phase(PG8_LAS unsigned char* lds, const Gemm g, const Sched& S, const Epi& E) {
    const int tid = threadIdx.x, wid = __builtin_amdgcn_readfirstlane(tid >> 6), lane = tid & 63, wr = wid >> 2, wc = wid & 3, fr = lane & 15, fq = lane >> 4;
    const int K = g.K, nt = K / BK;
    unsigned voffA[2], voffB[2];
#pragma unroll
    for (int i = 0; i < 2; ++i) { int R, C; stage_rc(tid * 16 + i * 8192, R, C); const int Rb = Epi::PERM ? ((R & ~31) + perm32(R & 31)) : R;
        voffA[i] = (unsigned)(R * K + C) * 2u; voffB[i] = (unsigned)(Rb * K + C) * 2u; }
    const size_t kstep = (size_t)(BK * 2);
    const size_t hstep = (size_t)HALF * K * 2;
    const size_t tstep = 2 * hstep;
    const unsigned ldsw = (unsigned)wid * 1024u;
    const int aoff = lds_byte(wr * 64 + fr, fq * 8), boff = lds_byte(wc * 32 + fr, fq * 8);
#define PG8_SA(b, h) (((b) * 2 + (h)) * HTB)
#define PG8_SB(b, h) ((4 + (b) * 2 + (h)) * HTB)
#define PG8_STAGE(bufoff, gbase, voff) do { _Pragma("unroll") for (int _i = 0; _i < 2; ++_i) \
        __builtin_amdgcn_global_load_lds((const unsigned*)((const char*)(gbase) + (voff)[_i]), (PG8_LAS unsigned*)(lds + (bufoff) + ldsw + _i * 8192), 16, 0, 0); } while (0)
#define PG8_LDA(dst, b, h) do { _Pragma("unroll") for (int m = 0; m < 4; ++m) _Pragma("unroll") for (int k = 0; k < 2; ++k) dst[m][k] = *(const PG8_LAS bf16x8*)(lds + PG8_SA(b, h) + aoff + m * 2048 + k * 1024); } while (0)
#define PG8_LDB(dst, b, h) do { _Pragma("unroll") for (int n = 0; n < 2; ++n) _Pragma("unroll") for (int k = 0; k < 2; ++k) dst[n][k] = *(const PG8_LAS bf16x8*)(lds + PG8_SB(b, h) + boff + n * 2048 + k * 1024); } while (0)
#define PG8_MMA(ai, bj, At, Bt) do { __builtin_amdgcn_s_setprio(1); _Pragma("unroll") for (int m = 0; m < 4; ++m) _Pragma("unroll") for (int n = 0; n < 2; ++n) _Pragma("unroll") for (int k = 0; k < 2; ++k) \
        acc[ai][bj][m][n] = __builtin_amdgcn_mfma_f32_16x16x32_bf16(Bt[n][k], At[m][k], acc[ai][bj][m][n], 0, 0, 0); __builtin_amdgcn_s_setprio(0); } while (0)
#define PG8_WAIT_V(n) asm volatile("s_waitcnt vmcnt(" #n ")" ::: "memory")
#define PG8_WAIT_L(n) asm volatile("s_waitcnt lgkmcnt(" #n ")" ::: "memory")
#define PG8_BAR __builtin_amdgcn_s_barrier()
#define PG8_SCHED __builtin_amdgcn_sched_barrier(0)
    Unit cur, nxt; int ui = 0;
    if (!S.next(0, cur)) return;
    f32x4 acc[2][2][4][2];
#pragma unroll
    for (int a = 0; a < 2; ++a)
#pragma unroll
        for (int b = 0; b < 2; ++b)
#pragma unroll
            for (int m = 0; m < 4; ++m)
#pragma unroll
                for (int n = 0; n < 2; ++n) acc[a][b][m][n] = (f32x4){0.f, 0.f, 0.f, 0.f};
    bf16x8 At[4][2], B0[2][2], B1[2][2];
    const char* cA = (const char*)g.A + (size_t)cur.pm * tstep; const char* cB = (const char*)g.Bt + (size_t)cur.pn * tstep;
    S.a_ready(cur);
    if constexpr (SP2) {
        PG8_STAGE(PG8_SB(0, 0), cB, voffB); PG8_STAGE(PG8_SB(0, 1), cB + hstep, voffB); PG8_STAGE(PG8_SA(0, 0), cA, voffA); PG8_STAGE(PG8_SA(0, 1), cA + hstep, voffA);
        if (wr == 1) PG8_BAR;
        PG8_WAIT_V(2); PG8_BAR;
        PG8_STAGE(PG8_SB(1, 0), cB + kstep, voffB); PG8_STAGE(PG8_SA(1, 0), cA + kstep, voffA); PG8_STAGE(PG8_SB(1, 1), cB + hstep + kstep, voffB);
        PG8_WAIT_V(6); PG8_BAR;
    } else {
        PG8_STAGE(PG8_SB(0, 0), cB, voffB); PG8_STAGE(PG8_SA(0, 0), cA, voffA); PG8_STAGE(PG8_SB(0, 1), cB + hstep, voffB); PG8_STAGE(PG8_SA(0, 1), cA + hstep, voffA);
        if (wr == 1) PG8_BAR;
        PG8_WAIT_V(4); PG8_BAR;
        PG8_STAGE(PG8_SB(1, 0), cB + kstep, voffB); PG8_STAGE(PG8_SA(1, 0), cA + kstep, voffA); PG8_STAGE(PG8_SB(1, 1), cB + hstep + kstep, voffB);
        PG8_WAIT_V(6); PG8_BAR;
    }
    for (;;) {
        const bool has_next = S.next(ui + 1, nxt);
        const char* nA = has_next ? (const char*)g.A + (size_t)nxt.pm * tstep : cA; const char* nB = has_next ? (const char*)g.Bt + (size_t)nxt.pn * tstep : cB;
        for (int t = 0; t < nt; t += 2) {
            const bool last = (t == nt - 2);
            const char* a1 = cA + (size_t)(t + 1) * kstep;
            const char* a2 = last ? nA : cA + (size_t)(t + 2) * kstep; const char* b2 = last ? nB : cB + (size_t)(t + 2) * kstep;
            const char* a3 = a2 + kstep; const char* b3 = b2 + kstep;
            if (last && has_next) S.a_ready(nxt);
            if constexpr (SP2) {
            PG8_LDB(B0, 0, 0); PG8_LDB(B1, 0, 1); PG8_SCHED; PG8_LDA(At, 0, 0); PG8_STAGE(PG8_SA(1, 1), a1 + hstep, voffA);
            PG8_WAIT_V(8); PG8_WAIT_L(0); PG8_BAR; PG8_MMA(0, 0, At, B0); PG8_MMA(0, 1, At, B1); PG8_BAR; PG8_SCHED;
            PG8_LDA(At, 0, 1); PG8_STAGE(PG8_SB(0, 0), b2, voffB); PG8_STAGE(PG8_SB(0, 1), b2 + hstep, voffB); PG8_STAGE(PG8_SA(0, 0), a2, voffA);
            PG8_WAIT_V(8); PG8_WAIT_L(0); PG8_BAR; PG8_MMA(1, 0, At, B0); PG8_MMA(1, 1, At, B1); PG8_BAR; PG8_SCHED;
            PG8_LDB(B0, 1, 0); PG8_LDB(B1, 1, 1); PG8_SCHED; PG8_LDA(At, 1, 0); PG8_STAGE(PG8_SA(0, 1), a2 + hstep, voffA);
            PG8_WAIT_V(8); PG8_WAIT_L(0); PG8_BAR; PG8_MMA(0, 0, At, B0); PG8_MMA(0, 1, At, B1); PG8_BAR; PG8_SCHED;
            PG8_LDA(At, 1, 1); PG8_STAGE(PG8_SB(1, 0), b3, voffB); PG8_STAGE(PG8_SB(1, 1), b3 + hstep, voffB); PG8_STAGE(PG8_SA(1, 0), a3, voffA);
            PG8_WAIT_V(8); PG8_WAIT_L(0); PG8_BAR; PG8_MMA(1, 0, At, B0); PG8_MMA(1, 1, At, B1); PG8_BAR; PG8_SCHED;
            } else {
            PG8_LDB(B0, 0, 0); PG8_SCHED; PG8_LDA(At, 0, 0); PG8_STAGE(PG8_SA(1, 1), a1 + hstep, voffA);
            PG8_WAIT_L(8); PG8_BAR; PG8_WAIT_L(0); PG8_MMA(0, 0, At, B0); PG8_BAR; PG8_SCHED;
            PG8_LDB(B1, 0, 1); PG8_STAGE(PG8_SB(0, 0), b2, voffB);
            PG8_BAR; PG8_WAIT_L(0); PG8_MMA(0, 1, At, B1); PG8_BAR;
            PG8_LDA(At, 0, 1); PG8_STAGE(PG8_SA(0, 0), a2, voffA);
            PG8_BAR; PG8_WAIT_L(0); PG8_MMA(1, 0, At, B0); PG8_BAR; PG8_SCHED;
            PG8_STAGE(PG8_SB(0, 1), b2 + hstep, voffB);
            PG8_WAIT_V(6); PG8_BAR; PG8_MMA(1, 1, At, B1); PG8_BAR;
            PG8_LDB(B0, 1, 0); PG8_SCHED; PG8_LDA(At, 1, 0); PG8_STAGE(PG8_SA(0, 1), a2 + hstep, voffA);
            PG8_WAIT_L(8); PG8_BAR; PG8_WAIT_L(0); PG8_MMA(0, 0, At, B0); PG8_BAR; PG8_SCHED;
            PG8_LDB(B1, 1, 1); PG8_STAGE(PG8_SB(1, 0), b3, voffB);
            PG8_BAR; PG8_WAIT_L(0); PG8_MMA(0, 1, At, B1); PG8_BAR;
            PG8_LDA(At, 1, 1); PG8_STAGE(PG8_SA(1, 0), a3, voffA);
            PG8_BAR; PG8_WAIT_L(0); PG8_MMA(1, 0, At, B0); PG8_BAR; PG8_SCHED;
            PG8_STAGE(PG8_SB(1, 1), b3 + hstep, voffB);
            PG8_WAIT_V(6); PG8_BAR; PG8_MMA(1, 1, At, B1); PG8_BAR;
            }
        }
        if constexpr (ALIGN_EPI) { if (wr == 0) PG8_BAR; }
        if constexpr (!Epi::AFTER_DRAIN) { E(acc, cur, wr, wc, fr, fq); S.done(cur); }
        if (!has_next) break;
#pragma unroll
        for (int a = 0; a < 2; ++a)
#pragma unroll
            for (int b = 0; b < 2; ++b)
#pragma unroll
                for (int m = 0; m < 4; ++m)
#pragma unroll
                    for (int n = 0; n < 2; ++n) acc[a][b][m][n] = (f32x4){0.f, 0.f, 0.f, 0.f};
        cur = nxt; cA = nA; cB = nB; ++ui;
        if constexpr (ALIGN_EPI) { if (wr == 1) PG8_BAR; }
    }
    PG8_WAIT_V(0);
    if constexpr (!ALIGN_EPI) { if (wr == 0) PG8_BAR; }
    PG8_BAR;
    if constexpr (Epi::AFTER_DRAIN) { E.fused(acc, cur, wr, wc, fr, fq, lds, wid, lane); S.done(cur); }
#undef PG8_SA
#undef PG8_SB
#undef PG8_STAGE
#undef PG8_LDA
#undef PG8_LDB
#undef PG8_MMA
#undef PG8_WAIT_V
#undef PG8_WAIT_L
#undef PG8_BAR
#undef PG8_SCHED
}
}

constexpr int NWAVES = 8, NTHR = 512;
constexpr int DM = 2048, SEQ = 4096, MTOK = 8192;
constexpr int SGW = 1024, RWW = 1024, NHEAD = 16, HDIM = 64;
constexpr int FEAT = 3488, FEATP = 3584, INW = 9632, INWP = 9728;
constexpr int DFF = 5632;
constexpr float NORM_EPS = 1e-6f, LN_EPS = 1e-5f, GN_EPS = 64e-5f;
#ifndef MK_SPLIT
#define MK_SPLIT 0
#endif
constexpr int NPHASE = 14;

constexpr size_t MiB = 1u << 20;
constexpr size_t WS_RSTD1 = 1 * MiB, WS_RSTD2 = 1 * MiB + 65536;
constexpr size_t WS_WPA = 2 * MiB, WS_WPB = 6 * MiB, WS_WOUT = 10 * MiB, WS_WG = 18 * MiB, WS_WU = 40 * MiB, WS_WD = 62 * MiB;
constexpr size_t WS_WIN = 84 * MiB, WS_XB = 122 * MiB;
constexpr size_t WS_MG = 154 * MiB, WS_SGB = 186 * MiB;
constexpr size_t WS_FEAT = 218 * MiB;
constexpr size_t WS_GG = 274 * MiB;
constexpr size_t WS_SR = 84 * MiB, WS_SK = 100 * MiB, WS_SV = 116 * MiB, WS_SKK = 132 * MiB;
constexpr size_t WS_OF = 218 * MiB, WS_OB = 234 * MiB, WS_YB = 250 * MiB;
constexpr size_t WS_X1B = 84 * MiB, WS_GT = 116 * MiB, WS_A3 = 204 * MiB;
constexpr size_t WS_END = 292 * MiB;
constexpr size_t DO_U = 0, DO_VG = 16 * MiB, DO_YA = 32 * MiB;
constexpr size_t DO_WF = 0, DO_AF = 16 * MiB, DO_WB = 32 * MiB, DO_AB = 48 * MiB;

constexpr int LDS_BYTES = 147456;

#define LAS __attribute__((address_space(3)))
typedef unsigned short bf16;
typedef unsigned v4u __attribute__((ext_vector_type(4)));
typedef unsigned v2u __attribute__((ext_vector_type(2)));
typedef float f32x4 __attribute__((ext_vector_type(4)));
#define LDS_WAIT() asm volatile("s_waitcnt lgkmcnt(0)" ::: "memory")
__device__ __forceinline__ unsigned f2bf(float f) { unsigned u = __float_as_uint(f); return (u + 0x7fffu + ((u >> 16) & 1u)) >> 16; }
__device__ __forceinline__ unsigned pk2(float lo, float hi) { return f2bf(lo) | (f2bf(hi) << 16); }
__device__ __forceinline__ float bf2f(unsigned b) { return __uint_as_float(b << 16); }
__device__ __forceinline__ float bflo(unsigned w) { return __uint_as_float(w << 16); }
__device__ __forceinline__ float bfhi(unsigned w) { return __uint_as_float(w & 0xffff0000u); }
__device__ __forceinline__ float sigmoidf_(float x) { return __builtin_amdgcn_rcpf(1.0f + __builtin_amdgcn_exp2f(-1.44269504089f * x)); }
__device__ __forceinline__ float wave_sum(float v) {
#pragma unroll
    for (int o = 1; o < 64; o <<= 1) v += __shfl_xor(v, o);
    return v;
}

namespace pg8 {
struct EpiIn {
    static constexpr bool PERM = true, AFTER_DRAIN = false;
    bf16_t *U, *VG, *FT, *SGA, *SGB; const float* rstd;
    __device__ __forceinline__ void operator()(const f32x4 (&acc)[2][2][4][2], const Unit& u, int wr, int wc, int fr, int fq) const {
        const int row0 = u.pm * BM + wr * 64 + fr; const int pn = u.pn;
        bf16_t* base; int ldc, colt, mode;
        if (pn < 4) { base = U; ldc = 1024; colt = pn * 256; mode = 0; }
        else if (pn < 8) { base = VG; ldc = 1024; colt = (pn - 4) * 256; mode = 0; }
        else if (pn < 22) { base = FT; ldc = FEATP; colt = (pn - 8) * 256; mode = 1; }
        else if (pn < 30) { base = SGA; ldc = 2048; colt = (pn - 22) * 256; mode = 2; }
        else { base = SGB; ldc = 2048; colt = (pn - 30) * 256; mode = 2; }
        const int col0 = colt + wc * 32 + 8 * fq;
#pragma unroll
        for (int ai = 0; ai < 2; ++ai)
#pragma unroll
            for (int m = 0; m < 4; ++m) { const int row = row0 + ai * HALF + m * 16; const float rs = rstd[row]; bf16_t* rowp = base + (size_t)row * ldc + col0;
#pragma unroll
                for (int bj = 0; bj < 2; ++bj) { f32x4 v0 = acc[ai][bj][m][0] * rs, v1 = acc[ai][bj][m][1] * rs;
                    if (mode == 0) { f32x2 a = gelu_pk((f32x2){v0[0], v0[1]}), b = gelu_pk((f32x2){v0[2], v0[3]}), c = gelu_pk((f32x2){v1[0], v1[1]}), d = gelu_pk((f32x2){v1[2], v1[3]});
                        v0 = (f32x4){a.x, a.y, b.x, b.y}; v1 = (f32x4){c.x, c.y, d.x, d.y}; }
                    else if (mode == 2) {
#pragma unroll
                        for (int j = 0; j < 4; ++j) { v0[j] = sigmoidf_(v0[j]); v1[j] = sigmoidf_(v1[j]); } }
                    u32x4 w; w.x = cvt_pk_bf16(v0[0], v0[1]); w.y = cvt_pk_bf16(v0[2], v0[3]); w.z = cvt_pk_bf16(v1[0], v1[1]); w.w = cvt_pk_bf16(v1[2], v1[3]);
                    *(u32x4*)(rowp + bj * HALF) = w; } }
    }
};
template <int SECOND> struct EpiProj {
    static constexpr bool PERM = true, AFTER_DRAIN = false;
    bf16_t* MG; const bf16_t* SGB;
    __device__ __forceinline__ void operator()(const f32x4 (&acc)[2][2][4][2], const Unit& u, int wr, int wc, int fr, int fq) const {
        const int row0 = u.pm * BM + wr * 64 + fr, col0 = u.pn * BM + wc * 32 + 8 * fq;
#pragma unroll
        for (int ai = 0; ai < 2; ++ai)
#pragma unroll
            for (int m = 0; m < 4; ++m) { const size_t off = (size_t)(row0 + ai * HALF + m * 16) * DM + col0;
#pragma unroll
                for (int bj = 0; bj < 2; ++bj) { const f32x4 a0 = acc[ai][bj][m][0], a1 = acc[ai][bj][m][1];
                    const u32x4 mg = *(const u32x4*)(MG + off + bj * HALF);
                    float o[8];
                    if (SECOND) { const u32x4 sg = *(const u32x4*)(SGB + off + bj * HALF);
                        o[0] = bflo(mg.x) + bflo(sg.x) * a0[0]; o[1] = bfhi(mg.x) + bfhi(sg.x) * a0[1]; o[2] = bflo(mg.y) + bflo(sg.y) * a0[2]; o[3] = bfhi(mg.y) + bfhi(sg.y) * a0[3];
                        o[4] = bflo(mg.z) + bflo(sg.z) * a1[0]; o[5] = bfhi(mg.z) + bfhi(sg.z) * a1[1]; o[6] = bflo(mg.w) + bflo(sg.w) * a1[2]; o[7] = bfhi(mg.w) + bfhi(sg.w) * a1[3]; }
                    else { o[0] = bflo(mg.x) * a0[0]; o[1] = bfhi(mg.x) * a0[1]; o[2] = bflo(mg.y) * a0[2]; o[3] = bfhi(mg.y) * a0[3];
                        o[4] = bflo(mg.z) * a1[0]; o[5] = bfhi(mg.z) * a1[1]; o[6] = bflo(mg.w) * a1[2]; o[7] = bfhi(mg.w) * a1[3]; }
                    u32x4 w; w.x = cvt_pk_bf16(o[0], o[1]); w.y = cvt_pk_bf16(o[2], o[3]); w.z = cvt_pk_bf16(o[4], o[5]); w.w = cvt_pk_bf16(o[6], o[7]);
                    *(u32x4*)(MG + off + bj * HALF) = w; } }
    }
};
struct EpiOut {
    static constexpr bool PERM = true, AFTER_DRAIN = false;
    const float* X; float* X1; bf16_t* X1B;
    __device__ __forceinline__ void operator()(const f32x4 (&acc)[2][2][4][2], const Unit& u, int wr, int wc, int fr, int fq) const {
        const int row0 = u.pm * BM + wr * 64 + fr, col0 = u.pn * BM + wc * 32 + 8 * fq;
#pragma unroll
        for (int ai = 0; ai < 2; ++ai)
#pragma unroll
            for (int m = 0; m < 4; ++m) { const size_t off = (size_t)(row0 + ai * HALF + m * 16) * DM + col0;
#pragma unroll
                for (int bj = 0; bj < 2; ++bj) { const f32x4 x0 = *(const f32x4*)(X + off + bj * HALF), x1 = *(const f32x4*)(X + off + bj * HALF + 4);
                    const f32x4 o0 = x0 + acc[ai][bj][m][0], o1 = x1 + acc[ai][bj][m][1];
                    *(f32x4*)(X1 + off + bj * HALF) = o0; *(f32x4*)(X1 + off + bj * HALF + 4) = o1;
                    u32x4 w; w.x = cvt_pk_bf16(o0[0], o0[1]); w.y = cvt_pk_bf16(o0[2], o0[3]); w.z = cvt_pk_bf16(o1[0], o1[1]); w.w = cvt_pk_bf16(o1[2], o1[3]);
                    *(u32x4*)(X1B + off + bj * HALF) = w; } }
    }
};
struct EpiGate {
    static constexpr bool PERM = true, AFTER_DRAIN = false;
    bf16_t* GT; const float* rstd;
    __device__ __forceinline__ void operator()(const f32x4 (&acc)[2][2][4][2], const Unit& u, int wr, int wc, int fr, int fq) const {
        const int row0 = u.pm * BM + wr * 64 + fr, col0 = u.pn * BM + wc * 32 + 8 * fq;
#pragma unroll
        for (int ai = 0; ai < 2; ++ai)
#pragma unroll
            for (int m = 0; m < 4; ++m) { const int row = row0 + ai * HALF + m * 16; const float rs = rstd[row]; bf16_t* rowp = GT + (size_t)row * DFF + col0;
#pragma unroll
                for (int bj = 0; bj < 2; ++bj) { const f32x4 v0 = acc[ai][bj][m][0] * rs, v1 = acc[ai][bj][m][1] * rs;
                    u32x4 w; w.x = cvt_pk_bf16(v0[0], v0[1]); w.y = cvt_pk_bf16(v0[2], v0[3]); w.z = cvt_pk_bf16(v1[0], v1[1]); w.w = cvt_pk_bf16(v1[2], v1[3]);
                    *(u32x4*)(rowp + bj * HALF) = w; } }
    }
};
struct EpiUp {
    static constexpr bool PERM = true, AFTER_DRAIN = false;
    const bf16_t* GT; bf16_t* A3; const float *rstd, *cw, *cb;
    __device__ __forceinline__ void operator()(const f32x4 (&acc)[2][2][4][2], const Unit& u, int wr, int wc, int fr, int fq) const {
        const int row0 = u.pm * BM + wr * 64 + fr, colb = u.pn * BM + wc * 32 + 8 * fq;
#pragma unroll
        for (int bj = 0; bj < 2; ++bj) { const int col = colb + bj * HALF;
            float w0[8], w1[8], w2[8], bb[8];
#pragma unroll
            for (int h = 0; h < 2; ++h) { const f32x4 a = *(const f32x4*)(cw + col + 4 * h), b = *(const f32x4*)(cw + DFF + col + 4 * h), c = *(const f32x4*)(cw + 2 * DFF + col + 4 * h), d = *(const f32x4*)(cb + col + 4 * h);
#pragma unroll
                for (int j = 0; j < 4; ++j) { w0[4 * h + j] = a[j]; w1[4 * h + j] = b[j]; w2[4 * h + j] = c[j]; bb[4 * h + j] = d[j]; } }
#pragma unroll
            for (int ai = 0; ai < 2; ++ai)
#pragma unroll
                for (int m = 0; m < 4; ++m) { const int row = row0 + ai * HALF + m * 16; const int t = row & (SEQ - 1); const float rs = rstd[row];
                    const bf16_t* gp = GT + (size_t)row * DFF + col;
                    const u32x4 gc = *(const u32x4*)gp; u32x4 gm = (u32x4){0u, 0u, 0u, 0u}, gx = (u32x4){0u, 0u, 0u, 0u};
                    if (t > 0) gm = *(const u32x4*)(gp - DFF);
                    if (t < SEQ - 1) gx = *(const u32x4*)(gp + DFF);
                    float o[8];
#pragma unroll
                    for (int e = 0; e < 8; ++e) { const unsigned cm = gm[e >> 1], cc = gc[e >> 1], cx = gx[e >> 1];
                        const float fm = (e & 1) ? bfhi(cm) : bflo(cm), fc = (e & 1) ? bfhi(cc) : bflo(cc), fx = (e & 1) ? bfhi(cx) : bflo(cx);
                        const float gt = w0[e] * fm + w1[e] * fc + w2[e] * fx + bb[e];
                        const float up = acc[ai][bj][m][e >> 2][e & 3] * rs;
                        o[e] = gt * sigmoidf_(gt) * up; }
                    u32x4 w; w.x = cvt_pk_bf16(o[0], o[1]); w.y = cvt_pk_bf16(o[2], o[3]); w.z = cvt_pk_bf16(o[4], o[5]); w.w = cvt_pk_bf16(o[6], o[7]);
                    *(u32x4*)(A3 + (size_t)row * DFF + col) = w; } }
    }
};
struct EpiDown {
    static constexpr bool PERM = true, AFTER_DRAIN = false;
    float* X1;
    __device__ __forceinline__ void operator()(const f32x4 (&acc)[2][2][4][2], const Unit& u, int wr, int wc, int fr, int fq) const {
        const int row0 = u.pm * BM + wr * 64 + fr, col0 = u.pn * BM + wc * 32 + 8 * fq;
#pragma unroll
        for (int ai = 0; ai < 2; ++ai)
#pragma unroll
            for (int m = 0; m < 4; ++m) { const size_t off = (size_t)(row0 + ai * HALF + m * 16) * DM + col0;
#pragma unroll
                for (int bj = 0; bj < 2; ++bj) { const f32x4 x0 = *(const f32x4*)(X1 + off + bj * HALF), x1 = *(const f32x4*)(X1 + off + bj * HALF + 4);
                    *(f32x4*)(X1 + off + bj * HALF) = x0 + acc[ai][bj][m][0]; *(f32x4*)(X1 + off + bj * HALF + 4) = x1 + acc[ai][bj][m][1]; } }
    }
};
}

struct Args { const float* in[33]; float* out; unsigned char* ws; int ph_lo, ph_hi; };
enum { I_X = 0, I_N1G, I_WIN, I_SLNG, I_SLNB, I_SW, I_SB, I_MUP, I_MUN, I_W0F, I_W2F, I_A0F, I_A2F, I_W0B, I_W2B, I_A0B, I_A2B, I_KK, I_KA, I_RK, I_G2, I_GNG, I_GNB,
       I_WPA, I_WPB, I_WOUT, I_N2G, I_WGATE, I_WUP, I_CW, I_CB, I_WDOWN, I_NFG };

__device__ __forceinline__ void p0_transpose_item(const float* W, int K, int N, bf16* WT, int drow0, const float* ksc, LAS float* scr, int k0, int n0, int lane) {
#pragma unroll 8
    for (int i = 0; i < 32; ++i) { const int kk = 2 * i + (lane >> 5); float v = W[(size_t)(k0 + kk) * N + n0 + (lane & 31)]; if (ksc) v *= ksc[k0 + kk]; scr[kk * 33 + (lane & 31)] = v; }
    LDS_WAIT(); asm volatile("" ::: "memory");
    const int c = lane & 7;
#pragma unroll
    for (int j = 0; j < 4; ++j) { const int n = (lane >> 3) + 8 * j; const LAS float* s = scr + (8 * c) * 33 + n;
        v4u o; o.x = pk2(s[0 * 33], s[1 * 33]); o.y = pk2(s[2 * 33], s[3 * 33]); o.z = pk2(s[4 * 33], s[5 * 33]); o.w = pk2(s[6 * 33], s[7 * 33]);
        *(v4u*)(WT + (size_t)(drow0 + n) * K + k0 + 8 * c) = o; }
    LDS_WAIT(); asm volatile("" ::: "memory");
}
__device__ __forceinline__ void phase_prologue(const Args& a, LAS unsigned char* lds, int G) {
    const int tid = threadIdx.x, lane = tid & 63, wave = tid >> 6;
    LAS float* scr = (LAS float*)(lds + wave * 16384);
    const int gw = blockIdx.x * NWAVES + wave, NGW = G * NWAVES;
    unsigned char* ws = a.ws;
    constexpr int I_IN = (DM / 64) * (INW / 32), I_PA = (SGW / 64) * (DM / 32), I_PB = I_PA, I_OUT = (DM / 64) * (DM / 32), I_G = (DM / 64) * (DFF / 32), I_U = I_G, I_D = (DFF / 64) * (DM / 32);
    constexpr int NITEMS = I_IN + I_PA + I_PB + I_OUT + I_G + I_U + I_D;
    for (int it = gw; it < NITEMS; it += NGW) {
        int r = it;
        if (r < I_IN) { const int nblk = INW / 32, kb = r / nblk, nb = r % nblk, n0 = 32 * nb; p0_transpose_item(a.in[I_WIN], DM, INW, (bf16*)(ws + WS_WIN), n0 < 5536 ? n0 : n0 + 96, a.in[I_N1G], scr, 64 * kb, n0, lane); continue; } r -= I_IN;
        if (r < I_PA) { const int nblk = DM / 32, kb = r / nblk, nb = r % nblk; p0_transpose_item(a.in[I_WPA], SGW, DM, (bf16*)(ws + WS_WPA), 32 * nb, nullptr, scr, 64 * kb, 32 * nb, lane); continue; } r -= I_PA;
        if (r < I_PB) { const int nblk = DM / 32, kb = r / nblk, nb = r % nblk; p0_transpose_item(a.in[I_WPB], RWW, DM, (bf16*)(ws + WS_WPB), 32 * nb, nullptr, scr, 64 * kb, 32 * nb, lane); continue; } r -= I_PB;
        if (r < I_OUT) { const int nblk = DM / 32, kb = r / nblk, nb = r % nblk; p0_transpose_item(a.in[I_WOUT], DM, DM, (bf16*)(ws + WS_WOUT), 32 * nb, nullptr, scr, 64 * kb, 32 * nb, lane); continue; } r -= I_OUT;
        if (r < I_G) { const int nblk = DFF / 32, kb = r / nblk, nb = r % nblk; p0_transpose_item(a.in[I_WGATE], DM, DFF, (bf16*)(ws + WS_WG), 32 * nb, a.in[I_N2G], scr, 64 * kb, 32 * nb, lane); continue; } r -= I_G;
        if (r < I_U) { const int nblk = DFF / 32, kb = r / nblk, nb = r % nblk; p0_transpose_item(a.in[I_WUP], DM, DFF, (bf16*)(ws + WS_WU), 32 * nb, a.in[I_N2G], scr, 64 * kb, 32 * nb, lane); continue; } r -= I_U;
        { const int nblk = DM / 32, kb = r / nblk, nb = r % nblk; p0_transpose_item(a.in[I_WDOWN], DFF, DM, (bf16*)(ws + WS_WD), 32 * nb, nullptr, scr, 64 * kb, 32 * nb, lane); }
    }
    { v4u* z = (v4u*)((bf16*)(ws + WS_WIN) + (size_t)5536 * DM); const int nz = 96 * DM * 2 / 16;
      for (int i = blockIdx.x * NTHR + tid; i < nz; i += G * NTHR) z[i] = (v4u){0u, 0u, 0u, 0u}; }
    const float* x = a.in[I_X]; bf16* xb = (bf16*)(ws + WS_XB); float* rstd1 = (float*)(ws + WS_RSTD1);
    for (int m = gw; m < MTOK; m += NGW) {
        const f32x4* xr = (const f32x4*)(x + (size_t)m * DM) + lane; f32x4 v[8]; float s = 0.f;
#pragma unroll
        for (int j = 0; j < 8; ++j) { v[j] = xr[64 * j]; s += (v[j].x * v[j].x + v[j].y * v[j].y) + (v[j].z * v[j].z + v[j].w * v[j].w); }
        s = wave_sum(s);
        if (lane == 0) rstd1[m] = 1.0f / sqrtf(s * (1.0f / DM) + NORM_EPS);
        unsigned long long* o8 = (unsigned long long*)(xb + (size_t)m * DM) + lane;
#pragma unroll
        for (int j = 0; j < 8; ++j) o8[64 * j] = (unsigned long long)pk2(v[j].x, v[j].y) | ((unsigned long long)pk2(v[j].z, v[j].w) << 32);
    }
}

__device__ __forceinline__ void phase_sgu(const Args& a, LAS unsigned char* lds, int G) {
    const int tid = threadIdx.x, lane = tid & 63, wave = tid >> 6;
    LAS float* wt = (LAS float*)lds;
    LAS float* vln = (LAS float*)(lds + 65536);
    LAS float* mu = (LAS float*)(lds + 131072);
    LAS float* rs = mu + 128;
    const bf16* U = (const bf16*)((unsigned char*)a.out + DO_U); const bf16* VG = (const bf16*)((unsigned char*)a.out + DO_VG); bf16* YA = (bf16*)((unsigned char*)a.out + DO_YA);
    const float* lng = a.in[I_SLNG]; const float* lnb = a.in[I_SLNB]; const float* sw = a.in[I_SW]; const float* sb = a.in[I_SB];
    for (int item = blockIdx.x; item < 512; item += G) {
        const int bc = item >> 3, g = item & 7, m0 = bc * 128;
        for (int rr = 0; rr < 16; ++rr) { const int r = wave * 16 + rr;
            const v4u* p = (const v4u*)(VG + (size_t)(m0 + r) * SGW + lane * 16); const v4u q0 = p[0], q1 = p[1];
            float f[16];
#pragma unroll
            for (int e = 0; e < 4; ++e) { f[2 * e] = bflo(q0[e]); f[2 * e + 1] = bfhi(q0[e]); f[8 + 2 * e] = bflo(q1[e]); f[8 + 2 * e + 1] = bfhi(q1[e]); }
            float s = 0.f;
#pragma unroll
            for (int e = 0; e < 16; ++e) s += f[e];
            const float mean = wave_sum(s) * (1.0f / SGW); float s2 = 0.f;
#pragma unroll
            for (int e = 0; e < 16; ++e) { const float d = f[e] - mean; s2 += d * d; }
            const float var = wave_sum(s2) * (1.0f / SGW);
            if (lane == 0) { mu[r] = mean; rs[r] = 1.0f / sqrtf(var + LN_EPS); } }
        for (int idx = tid; idx < 16384; idx += NTHR) { const int i = idx >> 7, j = idx & 127; wt[j * 128 + i] = sw[(size_t)g * 16384 + idx]; }
        __syncthreads();
        for (int idx = tid; idx < 16384; idx += NTHR) { const int j = idx >> 7, d = idx & 127; const int ch = g * 128 + d;
            vln[idx] = (bf2f(VG[(size_t)(m0 + j) * SGW + ch]) - mu[j]) * rs[j] * lng[ch] + lnb[ch]; }
        __syncthreads();
        const int d = tid & 127, ib = (tid >> 7) * 32;
        float acc[32];
#pragma unroll
        for (int i = 0; i < 32; ++i) acc[i] = 0.f;
        for (int j = 0; j < 128; ++j) { const float v = vln[j * 128 + d];
#pragma unroll
            for (int i4 = 0; i4 < 8; ++i4) { const f32x4 w4 = *(const LAS f32x4*)(wt + j * 128 + ib + 4 * i4);
                acc[4 * i4 + 0] += w4.x * v; acc[4 * i4 + 1] += w4.y * v; acc[4 * i4 + 2] += w4.z * v; acc[4 * i4 + 3] += w4.w * v; } }
#pragma unroll
        for (int ii = 0; ii < 32; ++ii) { const int i = ib + ii; const size_t off = (size_t)(m0 + i) * SGW + g * 128 + d;
            const float mixed = acc[ii] + sb[g * 128 + i];
            YA[off] = (bf16)f2bf(bf2f(U[off]) * mixed); }
        __syncthreads();
    }
}

constexpr int PT = 16;
__device__ __forceinline__ float softplusf_(float x) { return fmaxf(x, 0.f) + log1pf(expf(-fabsf(x))); }
__device__ __forceinline__ void phase_prep(const Args& a, LAS unsigned char* lds, int G) {
    const int tid = threadIdx.x;
    LAS float* act = (LAS float*)lds;
    unsigned char* ws = a.ws;
    const bf16* FT = (const bf16*)(ws + WS_FEAT);
    bf16 *SR = (bf16*)(ws + WS_SR), *SK = (bf16*)(ws + WS_SK), *SV = (bf16*)(ws + WS_SV), *SKK = (bf16*)(ws + WS_SKK), *GG = (bf16*)(ws + WS_GG);
    bf16 *WF = (bf16*)((unsigned char*)a.out + DO_WF), *AF = (bf16*)((unsigned char*)a.out + DO_AF), *WB = (bf16*)((unsigned char*)a.out + DO_WB), *AB = (bf16*)((unsigned char*)a.out + DO_AB);
    const float *mup = a.in[I_MUP], *mun = a.in[I_MUN];
    for (int tile = blockIdx.x; tile < MTOK / PT; tile += G) {
        const int m0 = tile * PT;
        for (int idx = tid; idx < 416 * PT; idx += NTHR) { const int t = idx / 416, j = idx - t * 416; const int m = m0 + t, ts = m & (SEQ - 1), col = 3072 + j;
            const float f = bf2f(FT[(size_t)m * FEATP + col]);
            const float fp = ts > 0 ? bf2f(FT[(size_t)(m - 1) * FEATP + col]) : 0.f, fn = ts < SEQ - 1 ? bf2f(FT[(size_t)(m + 1) * FEATP + col]) : 0.f;
            float xs = f + mup[col] * (fp - f) + mun[col] * (fn - f);
            if (j < 128) xs = tanhf(xs); else if (j >= 256) xs = sigmoidf_(xs);
            act[j * PT + t] = xs; }
        __syncthreads();
#pragma unroll 1
        for (int p = 0; p < 2; ++p) {
            const int c = tid + NTHR * p;
            float awf[PT], awb[PT], aaf[PT], aab[PT], ag[PT];
#pragma unroll
            for (int t = 0; t < PT; ++t) { awf[t] = 0.f; awb[t] = 0.f; aaf[t] = 0.f; aab[t] = 0.f; ag[t] = 0.f; }
#define LORA_ACC(ACC, WPTR, J0, NJ) for (int j = 0; j < (NJ); ++j) { const float wv = (WPTR)[(size_t)j * RWW + c]; \
            _Pragma("unroll") for (int t4 = 0; t4 < PT / 4; ++t4) { const f32x4 a4 = *(const LAS f32x4*)(act + ((J0) + j) * PT + 4 * t4); \
                ACC[4 * t4 + 0] += a4.x * wv; ACC[4 * t4 + 1] += a4.y * wv; ACC[4 * t4 + 2] += a4.z * wv; ACC[4 * t4 + 3] += a4.w * wv; } }
            LORA_ACC(awf, a.in[I_W2F], 0, 64)
            LORA_ACC(awb, a.in[I_W2B], 64, 64)
            LORA_ACC(aaf, a.in[I_A2F], 128, 64)
            LORA_ACC(aab, a.in[I_A2B], 192, 64)
            LORA_ACC(ag, a.in[I_G2], 256, 160)
#undef LORA_ACC
            const float w0f = a.in[I_W0F][c], w0b = a.in[I_W0B][c], a0f = a.in[I_A0F][c], a0b = a.in[I_A0B][c], kkc = a.in[I_KK][c];
            const float mpr = mup[c], mnr = mun[c], mpk = mup[1024 + c], mnk = mun[1024 + c], mpv = mup[2048 + c], mnv = mun[2048 + c];
            const int ts0 = m0 & (SEQ - 1);
            float rp, kp, vp, rc, kc, vc, rn, kn, vn;
            if (ts0 > 0) { const bf16* q = FT + (size_t)(m0 - 1) * FEATP + c; rp = bf2f(q[0]); kp = bf2f(q[1024]); vp = bf2f(q[2048]); } else { rp = 0.f; kp = 0.f; vp = 0.f; }
            { const bf16* q = FT + (size_t)m0 * FEATP + c; rc = bf2f(q[0]); kc = bf2f(q[1024]); vc = bf2f(q[2048]); }
#pragma unroll
            for (int t = 0; t < PT; ++t) { const int m = m0 + t;
                if (ts0 + t < SEQ - 1) { const bf16* q = FT + (size_t)(m + 1) * FEATP + c; rn = bf2f(q[0]); kn = bf2f(q[1024]); vn = bf2f(q[2048]); } else { rn = 0.f; kn = 0.f; vn = 0.f; }
                const float xr = rc + mpr * (rp - rc) + mnr * (rn - rc), xk = kc + mpk * (kp - kc) + mnk * (kn - kc), xv = vc + mpv * (vp - vc) + mnv * (vn - vc);
                const float k2 = xk * kkc; const float ss = wave_sum(k2 * k2); const float kkv = k2 * (1.0f / sqrtf(fmaxf(ss, 1e-24f)));
                const float ef = expf(-softplusf_(-(w0f + awf[t])) - 0.5f), eb = expf(-softplusf_(-(w0b + awb[t])) - 0.5f);
                const float omwf = 1.0f - expf(-ef), omwb = 1.0f - expf(-eb);
                const float af = sigmoidf_(a0f + aaf[t]), ab = sigmoidf_(a0b + aab[t]);
                const size_t o = (size_t)m * RWW + c;
                SR[o] = (bf16)f2bf(xr); SK[o] = (bf16)f2bf(xk); SV[o] = (bf16)f2bf(xv); SKK[o] = (bf16)f2bf(kkv);
                WF[o] = (bf16)f2bf(omwf); AF[o] = (bf16)f2bf(af); WB[o] = (bf16)f2bf(omwb); AB[o] = (bf16)f2bf(ab); GG[o] = (bf16)f2bf(ag[t]);
                rp = rc; kp = kc; vp = vc; rc = rn; kc = kn; vc = vn; }
        }
        __syncthreads();
    }
}

template <int CTRL> __device__ __forceinline__ float dpp_f(float x) { return __int_as_float(__builtin_amdgcn_update_dpp(0, __float_as_int(x), CTRL, 0xF, 0xF, true)); }
__device__ __forceinline__ float allreduce16(float x) { x += dpp_f<0xB1>(x); x += dpp_f<0x4E>(x); x += dpp_f<0x141>(x); x += dpp_f<0x140>(x); return x; }
constexpr int SCH = 16, SROW = 336;
__device__ __forceinline__ void phase_scan(const Args& a, LAS unsigned char* lds, int G) {
    const int tid = threadIdx.x, lane = tid & 63, wave = __builtin_amdgcn_readfirstlane(tid >> 6);
    LAS float* buf = (LAS float*)lds;
    unsigned char* ws = a.ws;
    const bf16 *SR = (const bf16*)(ws + WS_SR), *SK = (const bf16*)(ws + WS_SK), *SV = (const bf16*)(ws + WS_SV), *SKK = (const bf16*)(ws + WS_SKK);
    const float* kap = a.in[I_KA];
    constexpr int NCH = SEQ / SCH;
    for (int item = blockIdx.x; item < 256; item += G) {
        const int sid = item >> 2, q = item & 3, dir = sid & 1, h = (sid >> 1) & 15, b = sid >> 5;
        const bf16* OMW = (const bf16*)((unsigned char*)a.out + (dir ? DO_WB : DO_WF)); const bf16* AA = (const bf16*)((unsigned char*)a.out + (dir ? DO_AB : DO_AF));
        bf16* OO = (bf16*)(ws + (dir ? WS_OB : WS_OF));
        if (wave >= 4) {
            const int lt = tid - 256, s = lt >> 4, ch4 = (lt & 15) * 4;
            const f32x4 ka4 = *(const f32x4*)(kap + h * 64 + ch4);
            v2u rr, rk, rv, rkk, rw, ra;
#define SCAN_LOAD(c) do { const int st = (c) * SCH + s; const int t = dir ? (SEQ - 1 - st) : st; const size_t o = ((size_t)(b * SEQ + t)) * RWW + h * 64 + ch4; \
            rr = *(const v2u*)(SR + o); rk = *(const v2u*)(SK + o); rv = *(const v2u*)(SV + o); rkk = *(const v2u*)(SKK + o); rw = *(const v2u*)(OMW + o); ra = *(const v2u*)(AA + o); } while (0)
#define SCAN_WRITE(c) do { LAS float* rec = buf + (((c) & 1) * SCH + s) * SROW; \
            f32x4 fr_ = (f32x4){bflo(rr.x), bfhi(rr.x), bflo(rr.y), bfhi(rr.y)}, fk = (f32x4){bflo(rk.x), bfhi(rk.x), bflo(rk.y), bfhi(rk.y)}, fv = (f32x4){bflo(rv.x), bfhi(rv.x), bflo(rv.y), bfhi(rv.y)}; \
            f32x4 fkk = (f32x4){bflo(rkk.x), bfhi(rkk.x), bflo(rkk.y), bfhi(rkk.y)}, fw = (f32x4){bflo(rw.x), bfhi(rw.x), bflo(rw.y), bfhi(rw.y)}, fa = (f32x4){bflo(ra.x), bfhi(ra.x), bflo(ra.y), bfhi(ra.y)}; \
            *(LAS f32x4*)(rec + ch4) = fkk; *(LAS f32x4*)(rec + 64 + ch4) = 1.0f - fw; *(LAS f32x4*)(rec + 128 + ch4) = fkk * fa; \
            *(LAS f32x4*)(rec + 192 + ch4) = fk * (1.0f + (fa - 1.0f) * ka4); *(LAS f32x4*)(rec + 256 + ch4) = fr_; \
            if ((ch4 >> 4) == q) *(LAS f32x4*)(rec + 320 + (ch4 & 15)) = fv; } while (0)
            SCAN_LOAD(0); SCAN_WRITE(0); SCAN_LOAD(1);
            __syncthreads();
            for (int c = 0; c < NCH; ++c) {
                if (c + 1 < NCH) SCAN_WRITE(c + 1);
                if (c + 2 < NCH) SCAN_LOAD(c + 2);
                __syncthreads();
            }
#undef SCAN_LOAD
#undef SCAN_WRITE
        } else {
            const int rg = lane >> 4, cq = lane & 15, vl = 4 * wave + rg;
            float S0 = 0.f, S1 = 0.f, S2 = 0.f, S3 = 0.f;
            bf16* op = OO + (size_t)b * SEQ * RWW + h * 64 + 16 * q + vl;
            __syncthreads();
            for (int c = 0; c < NCH; ++c) {
                const LAS float* cb = buf + (c & 1) * SCH * SROW;
#pragma unroll
                for (int s = 0; s < SCH; ++s) { const LAS float* rec = cb + s * SROW;
                    const f32x4 kk4 = *(const LAS f32x4*)(rec + 4 * cq), w4 = *(const LAS f32x4*)(rec + 64 + 4 * cq), b4 = *(const LAS f32x4*)(rec + 128 + 4 * cq);
                    const f32x4 kd4 = *(const LAS f32x4*)(rec + 192 + 4 * cq), r4 = *(const LAS f32x4*)(rec + 256 + 4 * cq); const float vv = rec[320 + vl];
                    float p = (S0 * kk4.x + S1 * kk4.y) + (S2 * kk4.z + S3 * kk4.w);
                    p = allreduce16(p);
                    S0 = S0 * w4.x + vv * kd4.x; S1 = S1 * w4.y + vv * kd4.y; S2 = S2 * w4.z + vv * kd4.z; S3 = S3 * w4.w + vv * kd4.w;
                    S0 -= p * b4.x; S1 -= p * b4.y; S2 -= p * b4.z; S3 -= p * b4.w;
                    float o = (S0 * r4.x + S1 * r4.y) + (S2 * r4.z + S3 * r4.w);
                    o = allreduce16(o);
                    const int st = c * SCH + s; const int t = dir ? (SEQ - 1 - st) : st;
                    if (cq == 0) op[(size_t)t * RWW] = (bf16)f2bf(o); }
                __syncthreads();
            }
        }
    }
}

__device__ __forceinline__ void phase_post(const Args& a, int G) {
    const int tid = threadIdx.x;
    unsigned char* ws = a.ws;
    const bf16 *SR = (const bf16*)(ws + WS_SR), *SK = (const bf16*)(ws + WS_SK), *SV = (const bf16*)(ws + WS_SV), *GG = (const bf16*)(ws + WS_GG);
    const bf16 *AF = (const bf16*)((unsigned char*)a.out + DO_AF), *AB = (const bf16*)((unsigned char*)a.out + DO_AB);
    const bf16 *OF = (const bf16*)(ws + WS_OF), *OB = (const bf16*)(ws + WS_OB); bf16* YB = (bf16*)(ws + WS_YB);
    for (int p = 0; p < 2; ++p) { const int c = tid + NTHR * p;
        const float gng = a.in[I_GNG][c], gnb = a.in[I_GNB][c], ka = a.in[I_KA][c], rk = a.in[I_RK][c];
        for (int m = blockIdx.x; m < MTOK; m += G) { const size_t o = (size_t)m * RWW + c;
            const float ov = bf2f(OF[o]) + bf2f(OB[o]);
            const float mean = wave_sum(ov) * (1.0f / 64.0f); const float dv = ov - mean; const float var = wave_sum(dv * dv) * (1.0f / 64.0f);
            const float y = dv * (1.0f / sqrtf(var + GN_EPS)) * gng + gnb;
            const float r = bf2f(SR[o]), k = bf2f(SK[o]), v = bf2f(SV[o]), af = bf2f(AF[o]), ab = bf2f(AB[o]), g = bf2f(GG[o]);
            const float kfb = k * (2.0f + (af + ab - 2.0f) * ka);
            const float bs = wave_sum(r * kfb * rk);
            YB[o] = (bf16)f2bf((y + bs * v) * g); } }
}

__device__ __forceinline__ void phase_rstd2(const Args& a, int G) {
    const int tid = threadIdx.x, lane = tid & 63, wave = tid >> 6; const int gw = blockIdx.x * NWAVES + wave, NGW = G * NWAVES;
    float* rstd2 = (float*)(a.ws + WS_RSTD2);
    for (int m = gw; m < MTOK; m += NGW) { const f32x4* xr = (const f32x4*)(a.out + (size_t)m * DM) + lane; float s = 0.f;
#pragma unroll
        for (int j = 0; j < 8; ++j) { const f32x4 v = xr[64 * j]; s += (v.x * v.x + v.y * v.y) + (v.z * v.z + v.w * v.w); }
        s = wave_sum(s); if (lane == 0) rstd2[m] = 1.0f / sqrtf(s * (1.0f / DM) + NORM_EPS); }
}
__device__ __forceinline__ void phase_final(const Args& a, int G) {
    const int tid = threadIdx.x, lane = tid & 63, wave = tid >> 6; const int gw = blockIdx.x * NWAVES + wave, NGW = G * NWAVES;
    const f32x4* gf = (const f32x4*)a.in[I_NFG] + lane;
    for (int m = gw; m < MTOK; m += NGW) { f32x4* xr = (f32x4*)(a.out + (size_t)m * DM) + lane; f32x4 v[8]; float s = 0.f;
#pragma unroll
        for (int j = 0; j < 8; ++j) { v[j] = xr[64 * j]; s += (v[j].x * v[j].x + v[j].y * v[j].y) + (v[j].z * v[j].z + v[j].w * v[j].w); }
        const float rs = 1.0f / sqrtf(wave_sum(s) * (1.0f / DM) + NORM_EPS);
#pragma unroll
        for (int j = 0; j < 8; ++j) xr[64 * j] = v[j] * rs * gf[64 * j]; }
}

__global__ void __launch_bounds__(NTHR, 2) fwd_kernel(Args a) {
    extern __shared__ __attribute__((aligned(16))) unsigned char lds_raw[];
    LAS unsigned char* lds = (LAS unsigned char*)lds_raw;
    const int G = gridDim.x, lo = a.ph_lo, hi = a.ph_hi;
    unsigned char* ws = a.ws;
#define IN(k) (lo <= (k) && (k) < hi)
#define SEAM(k) do { if (IN(k) && IN((k) + 1)) { cg::this_grid().sync(); } } while (0)
    typedef pg8::bf16_t B;
    if (IN(0)) { phase_prologue(a, lds, G); } SEAM(0);
    if (IN(1)) { pg8::Gemm g{(const B*)(ws + WS_XB), (const B*)(ws + WS_WIN), MTOK, INWP, DM}; pg8::StaticOrder S; S.init(MTOK, INWP, G, (int)blockIdx.x);
        pg8::EpiIn E{(B*)((unsigned char*)a.out + DO_U), (B*)((unsigned char*)a.out + DO_VG), (B*)(ws + WS_FEAT), (B*)(ws + WS_MG), (B*)(ws + WS_SGB), (const float*)(ws + WS_RSTD1)};
        pg8::gemm_phase<pg8::EpiIn, pg8::StaticOrder, true, true>(lds, g, S, E); } SEAM(1);
    if (IN(2)) { phase_sgu(a, lds, G); } SEAM(2);
    if (IN(3)) { pg8::Gemm g{(const B*)((unsigned char*)a.out + DO_YA), (const B*)(ws + WS_WPA), MTOK, DM, SGW}; pg8::StaticOrder S; S.init(MTOK, DM, G, (int)blockIdx.x);
        pg8::EpiProj<0> E{(B*)(ws + WS_MG), nullptr};
        pg8::gemm_phase<pg8::EpiProj<0>, pg8::StaticOrder, true, true>(lds, g, S, E); } SEAM(3);
    if (IN(4)) { phase_prep(a, lds, G); } SEAM(4);
    if (IN(5)) { phase_scan(a, lds, G); } SEAM(5);
    if (IN(6)) { phase_post(a, G); } SEAM(6);
    if (IN(7)) { pg8::Gemm g{(const B*)(ws + WS_YB), (const B*)(ws + WS_WPB), MTOK, DM, RWW}; pg8::StaticOrder S; S.init(MTOK, DM, G, (int)blockIdx.x);
        pg8::EpiProj<1> E{(B*)(ws + WS_MG), (const B*)(ws + WS_SGB)};
        pg8::gemm_phase<pg8::EpiProj<1>, pg8::StaticOrder, true, true>(lds, g, S, E); } SEAM(7);
    if (IN(8)) { pg8::Gemm g{(const B*)(ws + WS_MG), (const B*)(ws + WS_WOUT), MTOK, DM, DM}; pg8::StaticOrder S; S.init(MTOK, DM, G, (int)blockIdx.x);
        pg8::EpiOut E{a.in[I_X], a.out, (B*)(ws + WS_X1B)};
        pg8::gemm_phase<pg8::EpiOut, pg8::StaticOrder, true, true>(lds, g, S, E); } SEAM(8);
    if (IN(9)) { phase_rstd2(a, G); } SEAM(9);
    if (IN(10)) { pg8::Gemm g{(const B*)(ws + WS_X1B), (const B*)(ws + WS_WG), MTOK, DFF, DM}; pg8::StaticOrder S; S.init(MTOK, DFF, G, (int)blockIdx.x);
        pg8::EpiGate E{(B*)(ws + WS_GT), (const float*)(ws + WS_RSTD2)};
        pg8::gemm_phase<pg8::EpiGate, pg8::StaticOrder, true, true>(lds, g, S, E); } SEAM(10);
    if (IN(11)) { pg8::Gemm g{(const B*)(ws + WS_X1B), (const B*)(ws + WS_WU), MTOK, DFF, DM}; pg8::StaticOrder S; S.init(MTOK, DFF, G, (int)blockIdx.x);
        pg8::EpiUp E{(const B*)(ws + WS_GT), (B*)(ws + WS_A3), (const float*)(ws + WS_RSTD2), a.in[I_CW], a.in[I_CB]};
        pg8::gemm_phase<pg8::EpiUp, pg8::StaticOrder, true, true>(lds, g, S, E); } SEAM(11);
    if (IN(12)) { pg8::Gemm g{(const B*)(ws + WS_A3), (const B*)(ws + WS_WD), MTOK, DM, DFF}; pg8::StaticOrder S; S.init(MTOK, DM, G, (int)blockIdx.x);
        pg8::EpiDown E{a.out};
        pg8::gemm_phase<pg8::EpiDown, pg8::StaticOrder, true, true>(lds, g, S, E); } SEAM(12);
    if (IN(13)) { phase_final(a, G); }
#undef IN
#undef SEAM
}

extern "C" void kernel_launch(void* const* d_in, const int* in_sizes, int n_in, void* d_out, int out_size, void* d_ws, size_t ws_size, hipStream_t stream) {
    static int grid = 0;
    if (grid == 0) {
        if (n_in != 33 || out_size != MTOK * DM || ws_size < WS_END) { fprintf(stderr, "kernel_launch: unexpected shapes (n_in %d, out %d, ws %zu); nothing launched\n", n_in, out_size, ws_size); grid = -1; return; }
        int dev = 0, cus = 0, per_cu = 0;
        if (hipGetDevice(&dev) != hipSuccess || hipDeviceGetAttribute(&cus, hipDeviceAttributeMultiprocessorCount, dev) != hipSuccess) { grid = -1; return; }
        if (hipFuncSetAttribute((const void*)fwd_kernel, hipFuncAttributeMaxDynamicSharedMemorySize, LDS_BYTES) != hipSuccess) { fprintf(stderr, "kernel_launch: hipFuncSetAttribute failed\n"); grid = -1; return; }
        if (hipOccupancyMaxActiveBlocksPerMultiprocessor(&per_cu, (const void*)fwd_kernel, NTHR, LDS_BYTES) != hipSuccess || per_cu < 1) { fprintf(stderr, "kernel_launch: occupancy query says %d blocks per CU\n", per_cu); (void)hipGetLastError(); per_cu = 1; }
        grid = cus;
    }
    if (grid < 0) return;
    Args a{};
    for (int i = 0; i < 33; ++i) a.in[i] = (const float*)d_in[i];
    a.out = (float*)d_out; a.ws = (unsigned char*)d_ws;
#if MK_SPLIT
    for (int p = 0; p < NPHASE; ++p) { a.ph_lo = p; a.ph_hi = p + 1; void* args[] = {&a};
        hipError_t e = hipLaunchCooperativeKernel((const void*)fwd_kernel, dim3(grid), dim3(NTHR), args, LDS_BYTES, stream);
        if (e != hipSuccess) { fprintf(stderr, "kernel_launch: launch of phase %d failed: %s\n", p, hipGetErrorString(e)); break; } }
#else
    a.ph_lo = 0; a.ph_hi = NPHASE; void* args[] = {&a};
    hipError_t e = hipLaunchCooperativeKernel((const void*)fwd_kernel, dim3(grid), dim3(NTHR), args, LDS_BYTES, stream);
    if (e != hipSuccess) fprintf(stderr, "kernel_launch: cooperative launch failed: %s (grid %d)\n", hipGetErrorString(e), grid);
#endif
}
```

```cpp
#include <hip/hip_runtime.h>
#include <hip/hip_cooperative_groups.h>
#include <cstdio>
#include <cstdint>
namespace cg = cooperative_groups;
namespace pg8 {
#define PG8_LAS __attribute__((address_space(3)))
typedef unsigned short bf16_t;
typedef short bf16x8 __attribute__((ext_vector_type(8)));
typedef float f32x4 __attribute__((ext_vector_type(4)));
typedef unsigned u32x4 __attribute__((ext_vector_type(4)));
constexpr int BM = 256, BK = 64, HALF = 128, HTB = HALF * BK * 2  , STAGE_BYTES = 8 * HTB, NXCD = 8, WGM = 4;

__host__ __device__ __forceinline__ int lds_byte(int r, int c) { const int st = (r >> 4) * 2 + (c >> 5), rr = r & 15, cc = c & 31, ob = rr * 64 + cc * 2; return st * 1024 + (ob ^ (((ob >> 9) & 1) << 5)); }
__host__ __device__ __forceinline__ void stage_rc(int b, int& R, int& C) { const int st = b / 1024, sb = b % 1024, swz = sb ^ (((sb >> 9) & 1) << 5); R = (st >> 1) * 16 + swz / 64; C = (st & 1) * 32 + (swz % 64) / 2; }
__host__ __device__ __forceinline__ int perm32(int rho) { const int n = rho >> 4, i = rho & 15; return 8 * (i >> 2) + 4 * n + (i & 3); }

struct Unit { int pm, pn; };
struct Gemm { const bf16_t* A; const bf16_t* Bt; int M, N, K; };

struct StaticOrder {
    int nM, nN, nwg, G, c;
    __host__ __device__ void init(int M, int N, int G_, int c_) { nM = M / BM; nN = N / BM; nwg = nM * nN; G = G_; c = c_; }
    __host__ __device__ bool next(int i, Unit& u) const {
        const long L = (long)i * G + c; if (L >= nwg) return false;
        int wgid = (int)L; { const int q = nwg / NXCD, r = nwg % NXCD, xcd = wgid % NXCD, off = wgid / NXCD; wgid = (xcd < r ? xcd * (q + 1) : r * (q + 1) + (xcd - r) * q) + off; }
        const int nig = WGM * nN, gid = wgid / nig, fm = gid * WGM, gsz = (nM - fm) < WGM ? (nM - fm) : WGM;
        u.pm = fm + ((wgid % nig) % gsz); u.pn = (wgid % nig) / gsz; return true;
    }
    __device__ __forceinline__ void a_ready(const Unit&) const {}
    __device__ __forceinline__ void done(const Unit&) const {}
};

__device__ __forceinline__ unsigned cvt_pk_bf16(float lo, float hi) { unsigned r; asm volatile("v_cvt_pk_bf16_f32 %0, %1, %2" : "=v"(r) : "v"(lo), "v"(hi)); return r; }
typedef float f32x2 __attribute__((ext_vector_type(2)));
__device__ __forceinline__ f32x2 gelu_pk(f32x2 v) {
    const f32x2 av = __builtin_elementwise_abs(v), d = av * 0.2316418882f + 1.0f;
    f32x2 t; t.x = __builtin_amdgcn_rcpf(d.x); t.y = __builtin_amdgcn_rcpf(d.y);
    f32x2 q = t * 0.5307027145f + (-0.7265760135f); q = q * t + 0.7107068705f; q = q * t + (-0.142248368f); q = q * t + 0.127414796f; q = q * t;
    const f32x2 s = (v * v) * (-0.72134752044f);
    f32x2 e; e.x = __builtin_amdgcn_exp2f(s.x); e.y = __builtin_amdgcn_exp2f(s.y);
    const f32x2 m = v * (q * e), r = v - m;
    f32x2 o; o.x = v.x < 0.f ? m.x : r.x; o.y = v.y < 0.f ? m.y : r.y; return o;
}

template <class Epi, class Sched, bool ALIGN_EPI = false, bool SP2 = false>
__device__ __forceinline__ void gemm_phase(PG8_LAS unsigned char* lds, const Gemm g, const Sched& S, const Epi& E, unsigned long long* tm = nullptr) {
#define PG8_TM(i) do { if (tm && blockIdx.x == 0 && threadIdx.x == 0) tm[i] = __builtin_amdgcn_s_memrealtime(); } while (0)
    PG8_TM(0);
    const int tid = threadIdx.x, wid = __builtin_amdgcn_readfirstlane(tid >> 6), lane = tid & 63, wr = wid >> 2, wc = wid & 3, fr = lane & 15, fq = lane >> 4;
    const int K = g.K, nt = K / BK;
    unsigned voffA[2], voffB[2];
#pragma unroll
    for (int i = 0; i < 2; ++i) { int R, C; stage_rc(tid * 16 + i * 8192, R, C); const int Rb = Epi::PERM ? ((R & ~31) + perm32(R & 31)) : R;
        voffA[i] = (unsigned)(R * K + C) * 2u; voffB[i] = (unsigned)(Rb * K + C) * 2u; }
    const size_t kstep = (size_t)(BK * 2);
    const size_t hstep = (size_t)HALF * K * 2;
    const size_t tstep = 2 * hstep;
    const unsigned ldsw = (unsigned)wid * 1024u;
    const int aoff = lds_byte(wr * 64 + fr, fq * 8), boff = lds_byte(wc * 32 + fr, fq * 8);
#define PG8_SA(b, h) (((b) * 2 + (h)) * HTB)
#define PG8_SB(b, h) ((4 + (b) * 2 + (h)) * HTB)
#define PG8_STAGE(bufoff, gbase, voff) do { _Pragma("unroll") for (int _i = 0; _i < 2; ++_i) \
        __builtin_amdgcn_global_load_lds((const unsigned*)((const char*)(gbase) + (voff)[_i]), (PG8_LAS unsigned*)(lds + (bufoff) + ldsw + _i * 8192), 16, 0, 0); } while (0)
#define PG8_LDA(dst, b, h) do { _Pragma("unroll") for (int m = 0; m < 4; ++m) _Pragma("unroll") for (int k = 0; k < 2; ++k) dst[m][k] = *(const PG8_LAS bf16x8*)(lds + PG8_SA(b, h) + aoff + m * 2048 + k * 1024); } while (0)
#define PG8_LDB(dst, b, h) do { _Pragma("unroll") for (int n = 0; n < 2; ++n) _Pragma("unroll") for (int k = 0; k < 2; ++k) dst[n][k] = *(const PG8_LAS bf16x8*)(lds + PG8_SB(b, h) + boff + n * 2048 + k * 1024); } while (0)
#define PG8_MMA(ai, bj, At, Bt) do { __builtin_amdgcn_s_setprio(1); _Pragma("unroll") for (int m = 0; m < 4; ++m) _Pragma("unroll") for (int n = 0; n < 2; ++n) _Pragma("unroll") for (int k = 0; k < 2; ++k) \
        acc[ai][bj][m][n] = __builtin_amdgcn_mfma_f32_16x16x32_bf16(Bt[n][k], At[m][k], acc[ai][bj][m][n], 0, 0, 0); __builtin_amdgcn_s_setprio(0); } while (0)
#define PG8_WAIT_V(n) asm volatile("s_waitcnt vmcnt(" #n ")" ::: "memory")
#define PG8_WAIT_L(n) asm volatile("s_waitcnt lgkmcnt(" #n ")" ::: "memory")
#define PG8_BAR __builtin_amdgcn_s_barrier()
#define PG8_SCHED __builtin_amdgcn_sched_barrier(0)
    Unit cur, nxt; int ui = 0;
    if (!S.next(0, cur)) return;
    f32x4 acc[2][2][4][2];
#pragma unroll
    for (int a = 0; a < 2; ++a)
#pragma unroll
        for (int b = 0; b < 2; ++b)
#pragma unroll
            for (int m = 0; m < 4; ++m)
#pragma unroll
                for (int n = 0; n < 2; ++n) acc[a][b][m][n] = (f32x4){0.f, 0.f, 0.f, 0.f};
    bf16x8 At[4][2], B0[2][2], B1[2][2];
    const char* cA = (const char*)g.A + (size_t)cur.pm * tstep; const char* cB = (const char*)g.Bt + (size_t)cur.pn * tstep;
    S.a_ready(cur);
    if constexpr (SP2) {
        PG8_STAGE(PG8_SB(0, 0), cB, voffB); PG8_STAGE(PG8_SB(0, 1), cB + hstep, voffB); PG8_STAGE(PG8_SA(0, 0), cA, voffA); PG8_STAGE(PG8_SA(0, 1), cA + hstep, voffA);
        if (wr == 1) PG8_BAR;
        PG8_WAIT_V(2); PG8_BAR;
        PG8_STAGE(PG8_SB(1, 0), cB + kstep, voffB); PG8_STAGE(PG8_SA(1, 0), cA + kstep, voffA); PG8_STAGE(PG8_SB(1, 1), cB + hstep + kstep, voffB);
        PG8_WAIT_V(6); PG8_BAR;
    } else {
        PG8_STAGE(PG8_SB(0, 0), cB, voffB); PG8_STAGE(PG8_SA(0, 0), cA, voffA); PG8_STAGE(PG8_SB(0, 1), cB + hstep, voffB); PG8_STAGE(PG8_SA(0, 1), cA + hstep, voffA);
        if (wr == 1) PG8_BAR;
        PG8_WAIT_V(4); PG8_BAR;
        PG8_STAGE(PG8_SB(1, 0), cB + kstep, voffB); PG8_STAGE(PG8_SA(1, 0), cA + kstep, voffA); PG8_STAGE(PG8_SB(1, 1), cB + hstep + kstep, voffB);
        PG8_WAIT_V(6); PG8_BAR;
    }
    PG8_TM(1);
    for (;;) {
        const bool has_next = S.next(ui + 1, nxt);
        const char* nA = has_next ? (const char*)g.A + (size_t)nxt.pm * tstep : cA; const char* nB = has_next ? (const char*)g.Bt + (size_t)nxt.pn * tstep : cB;
        for (int t = 0; t < nt; t += 2) {
            const bool last = (t == nt - 2);
            const char* a1 = cA + (size_t)(t + 1) * kstep;
            const char* a2 = last ? nA : cA + (size_t)(t + 2) * kstep; const char* b2 = last ? nB : cB + (size_t)(t + 2) * kstep;
            const char* a3 = a2 + kstep; const char* b3 = b2 + kstep;
            if (last && has_next) S.a_ready(nxt);
            if constexpr (SP2) {
            PG8_LDB(B0, 0, 0); PG8_LDB(B1, 0, 1); PG8_SCHED; PG8_LDA(At, 0, 0); PG8_STAGE(PG8_SA(1, 1), a1 + hstep, voffA);
            PG8_WAIT_V(8); PG8_WAIT_L(0); PG8_BAR; PG8_MMA(0, 0, At, B0); PG8_MMA(0, 1, At, B1); PG8_BAR; PG8_SCHED;
            PG8_LDA(At, 0, 1); PG8_STAGE(PG8_SB(0, 0), b2, voffB); PG8_STAGE(PG8_SB(0, 1), b2 + hstep, voffB); PG8_STAGE(PG8_SA(0, 0), a2, voffA);
            PG8_WAIT_V(8); PG8_WAIT_L(0); PG8_BAR; PG8_MMA(1, 0, At, B0); PG8_MMA(1, 1, At, B1); PG8_BAR; PG8_SCHED;
            PG8_LDB(B0, 1, 0); PG8_LDB(B1, 1, 1); PG8_SCHED; PG8_LDA(At, 1, 0); PG8_STAGE(PG8_SA(0, 1), a2 + hstep, voffA);
            PG8_WAIT_V(8); PG8_WAIT_L(0); PG8_BAR; PG8_MMA(0, 0, At, B0); PG8_MMA(0, 1, At, B1); PG8_BAR; PG8_SCHED;
            PG8_LDA(At, 1, 1); PG8_STAGE(PG8_SB(1, 0), b3, voffB); PG8_STAGE(PG8_SB(1, 1), b3 + hstep, voffB); PG8_STAGE(PG8_SA(1, 0), a3, voffA);
            PG8_WAIT_V(8); PG8_WAIT_L(0); PG8_BAR; PG8_MMA(1, 0, At, B0); PG8_MMA(1, 1, At, B1); PG8_BAR; PG8_SCHED;
            } else {
            PG8_LDB(B0, 0, 0); PG8_SCHED; PG8_LDA(At, 0, 0); PG8_STAGE(PG8_SA(1, 1), a1 + hstep, voffA);
            PG8_WAIT_L(8); PG8_BAR; PG8_WAIT_L(0); PG8_MMA(0, 0, At, B0); PG8_BAR; PG8_SCHED;
            PG8_LDB(B1, 0, 1); PG8_STAGE(PG8_SB(0, 0), b2, voffB);
            PG8_BAR; PG8_WAIT_L(0); PG8_MMA(0, 1, At, B1); PG8_BAR;
            PG8_LDA(At, 0, 1); PG8_STAGE(PG8_SA(0, 0), a2, voffA);
            PG8_BAR; PG8_WAIT_L(0); PG8_MMA(1, 0, At, B0); PG8_BAR; PG8_SCHED;
            PG8_STAGE(PG8_SB(0, 1), b2 + hstep, voffB);
            PG8_WAIT_V(6); PG8_BAR; PG8_MMA(1, 1, At, B1); PG8_BAR;
            PG8_LDB(B0, 1, 0); PG8_SCHED; PG8_LDA(At, 1, 0); PG8_STAGE(PG8_SA(0, 1), a2 + hstep, voffA);
            PG8_WAIT_L(8); PG8_BAR; PG8_WAIT_L(0); PG8_MMA(0, 0, At, B0); PG8_BAR; PG8_SCHED;
            PG8_LDB(B1, 1, 1); PG8_STAGE(PG8_SB(1, 0), b3, voffB);
            PG8_BAR; PG8_WAIT_L(0); PG8_MMA(0, 1, At, B1); PG8_BAR;
            PG8_LDA(At, 1, 1); PG8_STAGE(PG8_SA(1, 0), a3, voffA);
            PG8_BAR; PG8_WAIT_L(0); PG8_MMA(1, 0, At, B0); PG8_BAR; PG8_SCHED;
            PG8_STAGE(PG8_SB(1, 1), b3 + hstep, voffB);
            PG8_WAIT_V(6); PG8_BAR; PG8_MMA(1, 1, At, B1); PG8_BAR;
            }
        }
        PG8_TM(2);
        if constexpr (ALIGN_EPI) { if (wr == 0) PG8_BAR; }
        if constexpr (!Epi::AFTER_DRAIN) { E(acc, cur, wr, wc, fr, fq); S.done(cur); }
        PG8_TM(3);
        if (!has_next) break;
#pragma unroll
        for (int a = 0; a < 2; ++a)
#pragma unroll
            for (int b = 0; b < 2; ++b)
#pragma unroll
                for (int m = 0; m < 4; ++m)
#pragma unroll
                    for (int n = 0; n < 2; ++n) acc[a][b][m][n] = (f32x4){0.f, 0.f, 0.f, 0.f};
        cur = nxt; cA = nA; cB = nB; ++ui;
        if constexpr (ALIGN_EPI) { if (wr == 1) PG8_BAR; }
    }
    PG8_WAIT_V(0);
    if constexpr (!ALIGN_EPI) { if (wr == 0) PG8_BAR; }
    PG8_BAR;
    if constexpr (Epi::AFTER_DRAIN) { E.fused(acc, cur, wr, wc, fr, fq, lds, wid, lane); S.done(cur); }
    PG8_TM(4);
#undef PG8_TM
#undef PG8_SA
#undef PG8_SB
#undef PG8_STAGE
#undef PG8_LDA
#undef PG8_LDB
#undef PG8_MMA
#undef PG8_WAIT_V
#undef PG8_WAIT_L
#undef PG8_BAR
#undef PG8_SCHED
}
}

constexpr int NWAVES = 8, NTHR = 512;
constexpr int DM = 2048, SEQ = 4096, MTOK = 8192;
constexpr int SGW = 1024, RWW = 1024, NHEAD = 16, HDIM = 64;
constexpr int FEAT = 3488, FEATP = 3584, INW = 9632, INWP = 9728;
constexpr int DFF = 5632;
constexpr float NORM_EPS = 1e-6f, LN_EPS = 1e-5f, GN_EPS = 64e-5f;
#ifndef MK_SPLIT
#define MK_SPLIT 0
#endif
constexpr int NPHASE = 14;
#ifndef S1_V2
#define S1_V2 1
#endif
#ifndef USE_CG_SYNC
#define USE_CG_SYNC 0
#endif
#ifndef PROBE_TA
#define PROBE_TA 0
#endif
#ifndef PROBE_TB
#define PROBE_TB 0
#endif
#ifndef PROBE_SA
#define PROBE_SA 100.0f
#endif
#ifndef PROBE_SB
#define PROBE_SB 10.0f
#endif
#ifndef PROBE_BLK
#define PROBE_BLK 0
#endif
#ifndef PROBE_REP
#define PROBE_REP -1
#endif
#define REP(k) _Pragma("nounroll") for (int rep_ = 0; rep_ < (((k) == PROBE_REP) ? 2 - a.ph_lo : 1); ++rep_)

constexpr size_t MiB = 1u << 20;
constexpr size_t WS_CTL = 0, CTL_ZERO_BYTES = 65536;
constexpr size_t WS_RSTD1 = 1 * MiB, WS_RSTD2 = 1 * MiB + 65536, WS_W2T = 1 * MiB + 131072;
constexpr size_t WS_WPA = 2 * MiB, WS_WPB = 6 * MiB, WS_WOUT = 10 * MiB, WS_WG = 18 * MiB, WS_WU = 40 * MiB, WS_WD = 62 * MiB;
constexpr size_t WS_WIN = 84 * MiB, WS_XB = 122 * MiB;
constexpr size_t WS_MG = 154 * MiB, WS_SGB = 186 * MiB;
constexpr size_t WS_FEAT = 218 * MiB;
constexpr size_t WS_GG = 282 * MiB;
constexpr size_t WS_SR = 84 * MiB, WS_SK = 100 * MiB, WS_SV = 116 * MiB, WS_SKK = 132 * MiB;
constexpr size_t WS_BS = 149 * MiB;
constexpr size_t WS_XCH = 148 * MiB;
constexpr size_t WS_PART = 82 * MiB;
constexpr size_t CTL_CNT = 40960;
constexpr size_t WS_YA = 132 * MiB;
constexpr size_t WS_OF = 218 * MiB, WS_OB = 234 * MiB, WS_YB = 250 * MiB;
constexpr size_t WS_X1B = 84 * MiB, WS_GT = 116 * MiB, WS_A3 = 204 * MiB;
constexpr size_t WS_END = 298 * MiB;
constexpr size_t WS_CP = 18 * MiB, WS_CD = 50 * MiB, WS_CRQ = 218 * MiB, WS_COI = 250 * MiB;
constexpr size_t WS_U = 18 * MiB, WS_VG = 34 * MiB;
constexpr size_t DO_WF = 0, DO_AF = 16 * MiB, DO_WB = 32 * MiB, DO_AB = 48 * MiB;

constexpr int LDS_BYTES = 147456;
constexpr int LDS_BARST = 147456 - 64;

#define LAS __attribute__((address_space(3)))
typedef unsigned short bf16;
typedef unsigned v4u __attribute__((ext_vector_type(4)));
typedef unsigned v2u __attribute__((ext_vector_type(2)));
typedef float f32x4 __attribute__((ext_vector_type(4)));
#define LDS_WAIT() asm volatile("s_waitcnt lgkmcnt(0)" ::: "memory")
typedef __bf16 hwbf2 __attribute__((ext_vector_type(2)));
typedef float hwf2 __attribute__((ext_vector_type(2)));
__device__ __forceinline__ unsigned f2bf(float f) { return (unsigned)__builtin_bit_cast(unsigned short, (__bf16)f); }
__device__ __forceinline__ unsigned pk2(float lo, float hi) { const hwf2 v = {lo, hi}; return __builtin_bit_cast(unsigned, __builtin_convertvector(v, hwbf2)); }
__device__ __forceinline__ float bf2f(unsigned b) { return __uint_as_float(b << 16); }
__device__ __forceinline__ float bflo(unsigned w) { return __uint_as_float(w << 16); }
__device__ __forceinline__ float bfhi(unsigned w) { return __uint_as_float(w & 0xffff0000u); }
__device__ __forceinline__ float sigmoidf_(float x) { return __builtin_amdgcn_rcpf(1.0f + __builtin_amdgcn_exp2f(-1.44269504089f * x)); }
template <int CTRL> __device__ __forceinline__ float dpp_f(float x) { return __int_as_float(__builtin_amdgcn_update_dpp(0, __float_as_int(x), CTRL, 0xF, 0xF, true)); }
__device__ __forceinline__ float allreduce16(float x) { x += dpp_f<0xB1>(x); x += dpp_f<0x4E>(x); x += dpp_f<0x141>(x); x += dpp_f<0x140>(x); return x; }
__device__ __forceinline__ unsigned bl_off(int b, int h, int tblk, int k) { return ((((unsigned)(b * 16 + h) * (SEQ / 8) + (unsigned)tblk) * 64u + (unsigned)k) * 8u); }
__device__ __forceinline__ int crow(int e, int hh) { return (e & 3) + 8 * (e >> 2) + 4 * hh; }
__device__ __forceinline__ float wave_sum(float v) { v = allreduce16(v); v += __shfl_xor(v, 16); v += __shfl_xor(v, 32); return v; }

namespace pg8 {
struct EpiIn {
    static constexpr bool PERM = true, AFTER_DRAIN = false;
    bf16_t *U, *VG, *FT, *SGA, *SGB; const float* rstd; float* part;
    __device__ __forceinline__ void operator()(const f32x4 (&acc)[2][2][4][2], const Unit& u, int wr, int wc, int fr, int fq) const {
        const int row0 = u.pm * BM + wr * 64 + fr; const int pn = u.pn;
        bf16_t* base; int ldc, colt, mode;
        if (pn < 4) { base = U; ldc = 1024; colt = pn * 256; mode = 0; }
        else if (pn < 8) { base = VG; ldc = 1024; colt = (pn - 4) * 256; mode = 0; }
        else if (pn < 22) { base = FT; ldc = FEATP; colt = (pn - 8) * 256; mode = 1; }
        else if (pn < 30) { base = SGA; ldc = 2048; colt = (pn - 22) * 256; mode = 2; }
        else { base = SGB; ldc = 2048; colt = (pn - 30) * 256; mode = 2; }
        const int col0 = colt + wc * 32 + 8 * fq;
#pragma unroll
        for (int ai = 0; ai < 2; ++ai)
#pragma unroll
            for (int m = 0; m < 4; ++m) { const int row = row0 + ai * HALF + m * 16; const float rs = rstd[row]; bf16_t* rowp = base + (size_t)row * ldc + col0; float ps1 = 0.f, ps2 = 0.f;
#pragma unroll
                for (int bj = 0; bj < 2; ++bj) { f32x4 v0 = acc[ai][bj][m][0] * rs, v1 = acc[ai][bj][m][1] * rs;
                    if (mode == 0) { f32x2 a = gelu_pk((f32x2){v0[0], v0[1]}), b = gelu_pk((f32x2){v0[2], v0[3]}), c = gelu_pk((f32x2){v1[0], v1[1]}), d = gelu_pk((f32x2){v1[2], v1[3]});
                        v0 = (f32x4){a.x, a.y, b.x, b.y}; v1 = (f32x4){c.x, c.y, d.x, d.y}; }
                    else if (mode == 2) {
#pragma unroll
                        for (int j = 0; j < 4; ++j) { v0[j] = sigmoidf_(v0[j]); v1[j] = sigmoidf_(v1[j]); } }
                    u32x4 w; w.x = cvt_pk_bf16(v0[0], v0[1]); w.y = cvt_pk_bf16(v0[2], v0[3]); w.z = cvt_pk_bf16(v1[0], v1[1]); w.w = cvt_pk_bf16(v1[2], v1[3]);
                    *(u32x4*)(rowp + bj * HALF) = w;
                    if (pn >= 4 && pn < 8) { ps1 += ((v0[0] + v0[1]) + (v0[2] + v0[3])) + ((v1[0] + v1[1]) + (v1[2] + v1[3]));
                        ps2 += ((v0[0] * v0[0] + v0[1] * v0[1]) + (v0[2] * v0[2] + v0[3] * v0[3])) + ((v1[0] * v1[0] + v1[1] * v1[1]) + (v1[2] * v1[2] + v1[3] * v1[3])); } }
                if (pn >= 4 && pn < 8) { ps1 += __shfl_xor(ps1, 16); ps1 += __shfl_xor(ps1, 32); ps2 += __shfl_xor(ps2, 16); ps2 += __shfl_xor(ps2, 32);
                    if (fq == 0) { f32x2 o; o.x = ps1; o.y = ps2; *(f32x2*)(part + ((size_t)row * 16 + (pn - 4) * 4 + wc) * 2) = o; } } }
    }
};
template <int SECOND> struct EpiProj {
    static constexpr bool PERM = true, AFTER_DRAIN = false;
    bf16_t* MG; const bf16_t* SGB;
    __device__ __forceinline__ void operator()(const f32x4 (&acc)[2][2][4][2], const Unit& u, int wr, int wc, int fr, int fq) const {
        const int row0 = u.pm * BM + wr * 64 + fr, col0 = u.pn * BM + wc * 32 + 8 * fq;
#pragma unroll
        for (int ai = 0; ai < 2; ++ai)
#pragma unroll
            for (int bj = 0; bj < 2; ++bj) { u32x4 mgv[4], sgv[4];
#pragma unroll
                for (int m = 0; m < 4; ++m) { const size_t off = (size_t)(row0 + ai * HALF + m * 16) * DM + col0 + bj * HALF; mgv[m] = *(const u32x4*)(MG + off); if (SECOND) sgv[m] = *(const u32x4*)(SGB + off); }
#pragma unroll
                for (int m = 0; m < 4; ++m) { const size_t off = (size_t)(row0 + ai * HALF + m * 16) * DM + col0 + bj * HALF; const f32x4 a0 = acc[ai][bj][m][0], a1 = acc[ai][bj][m][1];
                    const u32x4 mg = mgv[m]; float o[8];
                    if (SECOND) { const u32x4 sg = sgv[m];
                        o[0] = bflo(mg.x) + bflo(sg.x) * a0[0]; o[1] = bfhi(mg.x) + bfhi(sg.x) * a0[1]; o[2] = bflo(mg.y) + bflo(sg.y) * a0[2]; o[3] = bfhi(mg.y) + bfhi(sg.y) * a0[3];
                        o[4] = bflo(mg.z) + bflo(sg.z) * a1[0]; o[5] = bfhi(mg.z) + bfhi(sg.z) * a1[1]; o[6] = bflo(mg.w) + bflo(sg.w) * a1[2]; o[7] = bfhi(mg.w) + bfhi(sg.w) * a1[3]; }
                    else { o[0] = bflo(mg.x) * a0[0]; o[1] = bfhi(mg.x) * a0[1]; o[2] = bflo(mg.y) * a0[2]; o[3] = bfhi(mg.y) * a0[3];
                        o[4] = bflo(mg.z) * a1[0]; o[5] = bfhi(mg.z) * a1[1]; o[6] = bflo(mg.w) * a1[2]; o[7] = bfhi(mg.w) * a1[3]; }
                    u32x4 w; w.x = cvt_pk_bf16(o[0], o[1]); w.y = cvt_pk_bf16(o[2], o[3]); w.z = cvt_pk_bf16(o[4], o[5]); w.w = cvt_pk_bf16(o[6], o[7]);
                    *(u32x4*)(MG + off) = w; } }
    }
};
struct EpiOut {
    static constexpr bool PERM = true, AFTER_DRAIN = false;
    const float* X; bf16_t* X1B;
    __device__ __forceinline__ void operator()(const f32x4 (&acc)[2][2][4][2], const Unit& u, int wr, int wc, int fr, int fq) const {
        const int row0 = u.pm * BM + wr * 64 + fr, col0 = u.pn * BM + wc * 32 + 8 * fq;
#pragma unroll
        for (int ai = 0; ai < 2; ++ai)
#pragma unroll
            for (int m = 0; m < 4; ++m) { const size_t off = (size_t)(row0 + ai * HALF + m * 16) * DM + col0;
#pragma unroll
                for (int bj = 0; bj < 2; ++bj) { const f32x4 x0 = *(const f32x4*)(X + off + bj * HALF), x1 = *(const f32x4*)(X + off + bj * HALF + 4);
                    const f32x4 o0 = x0 + acc[ai][bj][m][0], o1 = x1 + acc[ai][bj][m][1];
                    u32x4 w; w.x = cvt_pk_bf16(o0[0], o0[1]); w.y = cvt_pk_bf16(o0[2], o0[3]); w.z = cvt_pk_bf16(o1[0], o1[1]); w.w = cvt_pk_bf16(o1[2], o1[3]);
                    *(u32x4*)(X1B + off + bj * HALF) = w; } }
    }
};
struct EpiGate {
    static constexpr bool PERM = true, AFTER_DRAIN = false;
    bf16_t* GT; const float* rstd;
    __device__ __forceinline__ void operator()(const f32x4 (&acc)[2][2][4][2], const Unit& u, int wr, int wc, int fr, int fq) const {
        const int row0 = u.pm * BM + wr * 64 + fr, col0 = u.pn * BM + wc * 32 + 8 * fq;
#pragma unroll
        for (int ai = 0; ai < 2; ++ai)
#pragma unroll
            for (int m = 0; m < 4; ++m) { const int row = row0 + ai * HALF + m * 16; const float rs = rstd[row]; bf16_t* rowp = GT + (size_t)row * DFF + col0;
#pragma unroll
                for (int bj = 0; bj < 2; ++bj) { const f32x4 v0 = acc[ai][bj][m][0] * rs, v1 = acc[ai][bj][m][1] * rs;
                    u32x4 w; w.x = cvt_pk_bf16(v0[0], v0[1]); w.y = cvt_pk_bf16(v0[2], v0[3]); w.z = cvt_pk_bf16(v1[0], v1[1]); w.w = cvt_pk_bf16(v1[2], v1[3]);
                    *(u32x4*)(rowp + bj * HALF) = w; } }
    }
};
struct EpiUp {
    static constexpr bool PERM = true, AFTER_DRAIN = false;
    const bf16_t* GT; bf16_t* A3; const float *rstd, *cw, *cb;
    __device__ __forceinline__ void operator()(const f32x4 (&acc)[2][2][4][2], const Unit& u, int wr, int wc, int fr, int fq) const {
        const int row0 = u.pm * BM + wr * 64 + fr, colb = u.pn * BM + wc * 32 + 8 * fq;
        float rsv[2][4];
#pragma unroll
        for (int ai = 0; ai < 2; ++ai)
#pragma unroll
            for (int m = 0; m < 4; ++m) rsv[ai][m] = rstd[row0 + ai * HALF + m * 16];
        u32x4 gcA[4], gcB[4], gbA, gbB, gaA, gaB;
#define EU_LOAD(S, GC, GBF, GAF) do { const int bj_ = (S) >> 1, ai_ = (S) & 1; const int col_ = colb + bj_ * HALF; _Pragma("unroll") for (int m = 0; m < 4; ++m) GC[m] = *(const u32x4*)(GT + (size_t)(row0 + ai_ * HALF + m * 16) * DFF + col_); \
            int rb_ = row0 + ai_ * HALF - (fr == 0 ? 1 : 0); rb_ = rb_ < 0 ? 0 : rb_; int ra_ = row0 + ai_ * HALF + 48 + (fr == 15 ? 1 : 0); ra_ = ra_ > MTOK - 1 ? MTOK - 1 : ra_; \
            GBF = *(const u32x4*)(GT + (size_t)rb_ * DFF + col_); GAF = *(const u32x4*)(GT + (size_t)ra_ * DFF + col_); } while (0)
        EU_LOAD(0, gcA, gbA, gaA);
        float w0[8], w1[8], w2[8], bb[8];
#pragma unroll
        for (int s = 0; s < 4; ++s) { const int bj = s >> 1, ai = s & 1; const int col = colb + bj * HALF;
            if (ai == 0) {
#pragma unroll
                for (int h = 0; h < 2; ++h) { const f32x4 a = *(const f32x4*)(cw + col + 4 * h), b = *(const f32x4*)(cw + DFF + col + 4 * h), c = *(const f32x4*)(cw + 2 * DFF + col + 4 * h), d = *(const f32x4*)(cb + col + 4 * h);
#pragma unroll
                    for (int j = 0; j < 4; ++j) { w0[4 * h + j] = a[j]; w1[4 * h + j] = b[j]; w2[4 * h + j] = c[j]; bb[4 * h + j] = d[j]; } } }
            if (s >= 1 && s + 1 < 4) { if (s & 1) EU_LOAD(s + 1, gcA, gbA, gaA); else EU_LOAD(s + 1, gcB, gbB, gaB); }
            const bool zlo = ((row0 + ai * HALF) & (SEQ - 1)) == 0, zhi = ((row0 + ai * HALF + 48) & (SEQ - 1)) == SEQ - 1;
#pragma unroll
            for (int m = 0; m < 4; ++m) { const int row = row0 + ai * HALF + m * 16; const float rs = rsv[ai][m];
                const u32x4 gc = (s & 1) ? gcB[m] : gcA[m]; u32x4 gm, gx;
#pragma unroll
                for (int q = 0; q < 4; ++q) { gm[q] = (unsigned)__builtin_amdgcn_update_dpp(0, (int)gc[q], 0x111, 0xF, 0xF, true); gx[q] = (unsigned)__builtin_amdgcn_update_dpp(0, (int)gc[q], 0x101, 0xF, 0xF, true);
                    unsigned em, ex;
                    if (m == 0) em = zlo ? 0u : ((s & 1) ? gbB[q] : gbA[q]); else em = (unsigned)__builtin_amdgcn_update_dpp(0, (int)((s & 1) ? gcB[m - 1][q] : gcA[m - 1][q]), 0x121, 0xF, 0xF, true);
                    if (m == 3) ex = zhi ? 0u : ((s & 1) ? gaB[q] : gaA[q]); else ex = (unsigned)__builtin_amdgcn_update_dpp(0, (int)((s & 1) ? gcB[m + 1][q] : gcA[m + 1][q]), 0x12F, 0xF, 0xF, true);
                    if (fr == 0) gm[q] = em;
                    if (fr == 15) gx[q] = ex; }
                u32x4 w;
#pragma unroll
                for (int p = 0; p < 4; ++p) { const unsigned cm = gm[p], cc = gc[p], cx = gx[p];
                    const f32x2 fm = {bflo(cm), bfhi(cm)}, fc = {bflo(cc), bfhi(cc)}, fx = {bflo(cx), bfhi(cx)};
                    const f32x2 k0 = {w0[2 * p], w0[2 * p + 1]}, k1 = {w1[2 * p], w1[2 * p + 1]}, k2 = {w2[2 * p], w2[2 * p + 1]}, kb = {bb[2 * p], bb[2 * p + 1]};
                    const f32x2 gt = k0 * fm + (k1 * fc + (k2 * fx + kb));
                    const f32x2 ex2 = gt * (-1.44269504089f); f32x2 den; den.x = __builtin_amdgcn_exp2f(ex2.x); den.y = __builtin_amdgcn_exp2f(ex2.y); den = den + 1.0f;
                    f32x2 sg; sg.x = __builtin_amdgcn_rcpf(den.x); sg.y = __builtin_amdgcn_rcpf(den.y);
                    const f32x2 av = {acc[ai][bj][m][p >> 1][(2 * p) & 3], acc[ai][bj][m][p >> 1][((2 * p) & 3) + 1]};
                    const f32x2 o = (gt * sg) * (av * rs);
                    w[p] = cvt_pk_bf16(o.x, o.y); }
                *(u32x4*)(A3 + (size_t)row * DFF + col) = w; }
            if (s == 0) EU_LOAD(1, gcB, gbB, gaB); }
#undef EU_LOAD
    }
};
struct EpiDown {
    static constexpr bool PERM = true, AFTER_DRAIN = false;
    float* X1;
    __device__ __forceinline__ void operator()(const f32x4 (&acc)[2][2][4][2], const Unit& u, int wr, int wc, int fr, int fq) const {
        const int row0 = u.pm * BM + wr * 64 + fr, col0 = u.pn * BM + wc * 32 + 8 * fq;
#pragma unroll
        for (int ai = 0; ai < 2; ++ai)
#pragma unroll
            for (int m = 0; m < 4; ++m) { const size_t off = (size_t)(row0 + ai * HALF + m * 16) * DM + col0;
#pragma unroll
                for (int bj = 0; bj < 2; ++bj) { const f32x4 x0 = *(const f32x4*)(X1 + off + bj * HALF), x1 = *(const f32x4*)(X1 + off + bj * HALF + 4);
                    *(f32x4*)(X1 + off + bj * HALF) = x0 + acc[ai][bj][m][0]; *(f32x4*)(X1 + off + bj * HALF + 4) = x1 + acc[ai][bj][m][1]; } }
    }
};
struct EpiOutNorm {
    static constexpr bool PERM = true, AFTER_DRAIN = true;
    const float* X; bf16_t* X1B; float* rstd2; float* xbuf; unsigned* cnt;
    __device__ __forceinline__ void fused(f32x4 (&acc)[2][2][4][2], const Unit& u, int wr, int wc, int fr, int fq, PG8_LAS unsigned char* lds, int wid, int lane) const {
        PG8_LAS float* P = (PG8_LAS float*)lds;
        const int row0 = u.pm * BM + wr * 64 + fr, col0 = u.pn * BM + wc * 32 + 8 * fq;
#pragma unroll
        for (int ai = 0; ai < 2; ++ai) { f32x4 xv[4][2][2];
#pragma unroll
            for (int m = 0; m < 4; ++m)
#pragma unroll
                for (int bj = 0; bj < 2; ++bj) { const size_t off = (size_t)(row0 + ai * HALF + m * 16) * DM + col0 + bj * HALF; xv[m][bj][0] = *(const f32x4*)(X + off); xv[m][bj][1] = *(const f32x4*)(X + off + 4); }
#pragma unroll
            for (int m = 0; m < 4; ++m) { const size_t off = (size_t)(row0 + ai * HALF + m * 16) * DM + col0; float q = 0.f;
#pragma unroll
                for (int bj = 0; bj < 2; ++bj) { const f32x4 o0 = xv[m][bj][0] + acc[ai][bj][m][0], o1 = xv[m][bj][1] + acc[ai][bj][m][1];
                    u32x4 w; w.x = cvt_pk_bf16(o0[0], o0[1]); w.y = cvt_pk_bf16(o0[2], o0[3]); w.z = cvt_pk_bf16(o1[0], o1[1]); w.w = cvt_pk_bf16(o1[2], o1[3]);
                    *(u32x4*)(X1B + off + bj * HALF) = w;
#pragma unroll
                    for (int e = 0; e < 4; ++e) { const float lo = bflo(w[e]), hi = bfhi(w[e]); q += lo * lo + hi * hi; } }
                q += __shfl_xor(q, 16); q += __shfl_xor(q, 32);
                if (fq == 0) P[(ai * HALF + wr * 64 + m * 16 + fr) * 4 + wc] = q; } }
        asm volatile("s_waitcnt lgkmcnt(0)" ::: "memory"); __builtin_amdgcn_s_barrier(); asm volatile("" ::: "memory");
        const int row = wid * 32 + (lane & 31);
        if (lane < 32) { const float t = (P[row * 4 + 0] + P[row * 4 + 1]) + (P[row * 4 + 2] + P[row * 4 + 3]);
            __hip_atomic_store(xbuf + (size_t)(u.pm * BM + row) * 8 + u.pn, t, __ATOMIC_RELAXED, __HIP_MEMORY_SCOPE_AGENT); }
        asm volatile("s_waitcnt vmcnt(0)" ::: "memory");
        if (lane == 0) __hip_atomic_fetch_add(cnt + 64 * u.pm, 1u, __ATOMIC_RELAXED, __HIP_MEMORY_SCOPE_AGENT);
        if (u.pn == 0) {
            if (wid == 0) { unsigned spins = 0;
                while ((unsigned)__builtin_amdgcn_readfirstlane(__hip_atomic_load(cnt + 64 * u.pm, __ATOMIC_RELAXED, __HIP_MEMORY_SCOPE_AGENT)) < 64u) { __builtin_amdgcn_s_sleep(2); if (++spins > (1u << 22)) break; }
                __builtin_amdgcn_fence(__ATOMIC_ACQUIRE, "agent"); }
            asm volatile("s_waitcnt vmcnt(0) lgkmcnt(0)" ::: "memory"); __builtin_amdgcn_s_barrier(); asm volatile("" ::: "memory");
            if (lane < 32) { const float* sl = xbuf + (size_t)(u.pm * BM + row) * 8; float t = 0.f;
#pragma unroll
                for (int q = 0; q < 8; ++q) t += __hip_atomic_load(sl + q, __ATOMIC_RELAXED, __HIP_MEMORY_SCOPE_AGENT);
                rstd2[u.pm * BM + row] = 1.0f / sqrtf(t * (1.0f / DM) + 1e-6f); } }
    }
};
struct EpiDownNorm {
    static constexpr bool PERM = true, AFTER_DRAIN = true;
    const bf16_t* X1B; float* OUT; const float* gf; float* xbuf; unsigned* cnt;
    __device__ __forceinline__ void fused(f32x4 (&acc)[2][2][4][2], const Unit& u, int wr, int wc, int fr, int fq, PG8_LAS unsigned char* lds, int wid, int lane) const {
        PG8_LAS float* P = (PG8_LAS float*)lds;
        PG8_LAS float* S = (PG8_LAS float*)(lds + 8192);
        const int row0 = u.pm * BM + wr * 64 + fr, col0 = u.pn * BM + wc * 32 + 8 * fq;
#pragma unroll
        for (int ai = 0; ai < 2; ++ai) { u32x4 xwv[4][2];
#pragma unroll
            for (int m = 0; m < 4; ++m)
#pragma unroll
                for (int bj = 0; bj < 2; ++bj) xwv[m][bj] = *(const u32x4*)(X1B + (size_t)(row0 + ai * HALF + m * 16) * DM + col0 + bj * HALF);
#pragma unroll
            for (int m = 0; m < 4; ++m)
#pragma unroll
                for (int bj = 0; bj < 2; ++bj) { const u32x4 xw = xwv[m][bj];
                    acc[ai][bj][m][0] += (f32x4){bflo(xw.x), bfhi(xw.x), bflo(xw.y), bfhi(xw.y)}; acc[ai][bj][m][1] += (f32x4){bflo(xw.z), bfhi(xw.z), bflo(xw.w), bfhi(xw.w)}; } }
#pragma unroll
        for (int ai = 0; ai < 2; ++ai)
#pragma unroll
            for (int m = 0; m < 4; ++m) { float q = 0.f;
#pragma unroll
                for (int bj = 0; bj < 2; ++bj)
#pragma unroll
                    for (int n = 0; n < 2; ++n) { const f32x4 x = acc[ai][bj][m][n]; q += (x[0] * x[0] + x[1] * x[1]) + (x[2] * x[2] + x[3] * x[3]); }
                q += __shfl_xor(q, 16); q += __shfl_xor(q, 32);
                if (fq == 0) P[(ai * HALF + wr * 64 + m * 16 + fr) * 4 + wc] = q; }
        asm volatile("s_waitcnt lgkmcnt(0)" ::: "memory"); __builtin_amdgcn_s_barrier(); asm volatile("" ::: "memory");
        const int row = wid * 32 + (lane & 31);
        if (lane < 32) { const float t = (P[row * 4 + 0] + P[row * 4 + 1]) + (P[row * 4 + 2] + P[row * 4 + 3]);
            __hip_atomic_store(xbuf + (size_t)(u.pm * BM + row) * 8 + u.pn, t, __ATOMIC_RELAXED, __HIP_MEMORY_SCOPE_AGENT); }
        asm volatile("s_waitcnt vmcnt(0)" ::: "memory");
        if (lane == 0) __hip_atomic_fetch_add(cnt + 64 * u.pm, 1u, __ATOMIC_RELAXED, __HIP_MEMORY_SCOPE_AGENT);
        if (wid == 0) { unsigned spins = 0;
            while ((unsigned)__builtin_amdgcn_readfirstlane(__hip_atomic_load(cnt + 64 * u.pm, __ATOMIC_RELAXED, __HIP_MEMORY_SCOPE_AGENT)) < 64u) { __builtin_amdgcn_s_sleep(2); if (++spins > (1u << 22)) break; }
            __builtin_amdgcn_fence(__ATOMIC_ACQUIRE, "agent"); }
        asm volatile("s_waitcnt vmcnt(0) lgkmcnt(0)" ::: "memory"); __builtin_amdgcn_s_barrier(); asm volatile("" ::: "memory");
        if (lane < 32) { const float* sl = xbuf + (size_t)(u.pm * BM + row) * 8; float t = 0.f;
#pragma unroll
            for (int q = 0; q < 8; ++q) t += __hip_atomic_load(sl + q, __ATOMIC_RELAXED, __HIP_MEMORY_SCOPE_AGENT);
            S[row] = 1.0f / sqrtf(t * (1.0f / DM) + 1e-6f); }
        asm volatile("s_waitcnt lgkmcnt(0)" ::: "memory"); __builtin_amdgcn_s_barrier(); asm volatile("" ::: "memory");
#pragma unroll
        for (int bj = 0; bj < 2; ++bj) { const f32x4 g0 = *(const f32x4*)(gf + col0 + bj * HALF), g1 = *(const f32x4*)(gf + col0 + bj * HALF + 4);
#pragma unroll
            for (int ai = 0; ai < 2; ++ai)
#pragma unroll
                for (int m = 0; m < 4; ++m) { const int r = ai * HALF + wr * 64 + m * 16 + fr; const float rs = S[r]; const size_t off = (size_t)(u.pm * BM + r) * DM + col0 + bj * HALF;
                    *(f32x4*)(OUT + off) = acc[ai][bj][m][0] * rs * g0; *(f32x4*)(OUT + off + 4) = acc[ai][bj][m][1] * rs * g1; } }
    }
};
}

#define XB_TMO      128
#define XB_XCNT(j)  (256  + 64 * (j))
#define XB_XSUB(j)  (1280 + 64 * (j))
#define XB_XGEN(j)  (2304 + 64 * (j))
#define XB_TOP      3328
#define XB_TOPGEN   3392
#define XCD_BAR_WORDS 3456
#define XB_SPIN_CAP (1u << 18)

__device__ __forceinline__ unsigned xb_ld(unsigned* p)              { return __hip_atomic_load(p, __ATOMIC_RELAXED, __HIP_MEMORY_SCOPE_AGENT); }
__device__ __forceinline__ unsigned xb_add(unsigned* p, unsigned v) { return __hip_atomic_fetch_add(p, v, __ATOMIC_RELAXED, __HIP_MEMORY_SCOPE_AGENT); }
__device__ __forceinline__ unsigned xb_xcc_id() { return (unsigned)__builtin_amdgcn_s_getreg((3 << 11) | 20) & 0xFu; }
#define XB_SPIN(cond, bar) do { unsigned _sp = 0; while (cond) { __builtin_amdgcn_s_sleep(1); \
    if ((++_sp & 255u) == 0u) { if (xb_ld(&(bar)[XB_TMO])) break; if (_sp > XB_SPIN_CAP) { atomicAdd(&(bar)[XB_TMO], 1u); break; } } } } while (0)

struct XcdBarrier {
    unsigned* bar; unsigned x;
    volatile LAS unsigned* st;
};

__device__ __forceinline__ XcdBarrier xcd_barrier_post(unsigned* bar, volatile LAS unsigned* st) {
    XcdBarrier b; b.bar = bar; b.x = xb_xcc_id(); b.st = st;
    if (threadIdx.x == 0) (void)xb_add(&bar[XB_XCNT(b.x)], 1u);
    return b;
}
__device__ __forceinline__ void xcd_barrier_complete(unsigned* bar, unsigned x, unsigned& nloc, unsigned& nx) {
    const unsigned G = gridDim.x * gridDim.y * gridDim.z;
    unsigned sum, cnt, mine, sp = 0u;
    for (;;) {
        sum = 0u; cnt = 0u; mine = 0u;
#pragma unroll
        for (unsigned j = 0; j < 16; ++j) { const unsigned c = xb_ld(&bar[XB_XCNT(j)]); sum += c; cnt += (c > 0u) ? 1u : 0u; mine = (j == x) ? c : mine; }
        if (sum == G) break;
        __builtin_amdgcn_s_sleep(1);
        if ((++sp & 255u) == 0u) { if (xb_ld(&bar[XB_TMO])) break; if (sp > XB_SPIN_CAP) { atomicAdd(&bar[XB_TMO], 1u); break; } }
    }
    nloc = mine > 0u ? mine : 1u; nx = cnt > 0u ? cnt : 1u;
}

__device__ __forceinline__ void xcd_barrier(const XcdBarrier& b) {
    asm volatile("s_waitcnt vmcnt(0)" ::: "memory");
    __syncthreads();
    if (threadIdx.x == 0) {
        unsigned* bar = b.bar;
        __builtin_amdgcn_s_waitcnt(0);
        unsigned nloc = b.st[0], nx = b.st[1];
        if (nloc == 0u) { xcd_barrier_complete(bar, b.x, nloc, nx); b.st[0] = nloc; b.st[1] = nx; }
        const unsigned old = xb_add(&bar[XB_XSUB(b.x)], 1u);
        const unsigned gen = old / nloc;
        if (old + 1u == (gen + 1u) * nloc) {
            __builtin_amdgcn_fence(__ATOMIC_RELEASE, "agent");
            asm volatile("s_waitcnt vmcnt(0)" ::: "memory");
            const unsigned og = xb_add(&bar[XB_TOP], 1u);
            const unsigned tg = og / nx;
            if (og + 1u == (tg + 1u) * nx) xb_add(&bar[XB_TOPGEN], 1u);
            else XB_SPIN(xb_ld(&bar[XB_TOPGEN]) == tg, bar);
            __builtin_amdgcn_fence(__ATOMIC_ACQUIRE, "agent");
            xb_add(&bar[XB_XGEN(b.x)], 1u);
            asm volatile("s_waitcnt vmcnt(0)" ::: "memory");
        } else {
            XB_SPIN(xb_ld(&bar[XB_XGEN(b.x)]) == gen, bar);
            __builtin_amdgcn_fence(__ATOMIC_ACQUIRE, "agent");
            asm volatile("s_waitcnt vmcnt(0)" ::: "memory");
        }
    }
    __syncthreads();
}

struct Args { const float* in[33]; float* out; unsigned char* ws; int ph_lo, ph_hi; };
enum { I_X = 0, I_N1G, I_WIN, I_SLNG, I_SLNB, I_SW, I_SB, I_MUP, I_MUN, I_W0F, I_W2F, I_A0F, I_A2F, I_W0B, I_W2B, I_A0B, I_A2B, I_KK, I_KA, I_RK, I_G2, I_GNG, I_GNB,
       I_WPA, I_WPB, I_WOUT, I_N2G, I_WGATE, I_WUP, I_CW, I_CB, I_WDOWN, I_NFG };

struct TpDesc { const float* W; bf16* WT; const float* ksc; int K, N, drow0, k0, n0; };
__device__ __forceinline__ void tp_load(const TpDesc& d, int lane, float (&vv)[32], float (&sc)[32]) {
#pragma unroll
    for (int i = 0; i < 32; ++i) { const int kk = 2 * i + (lane >> 5); vv[i] = __builtin_nontemporal_load(d.W + ((size_t)(d.k0 + kk) * d.N + d.n0 + (lane & 31))); }
#pragma unroll
    for (int i = 0; i < 32; ++i) sc[i] = d.ksc ? d.ksc[d.k0 + 2 * i + (lane >> 5)] : 1.0f;
}
template <bool NTS> __device__ __forceinline__ void tp_store(const TpDesc& d, LAS float* scr, int lane, const float (&vv)[32], const float (&sc)[32]) {
#pragma unroll
    for (int i = 0; i < 32; ++i) { const int kk = 2 * i + (lane >> 5); scr[kk * 33 + (lane & 31)] = vv[i] * sc[i]; }
    LDS_WAIT(); asm volatile("" ::: "memory");
    const int c = lane & 7;
#pragma unroll
    for (int j = 0; j < 4; ++j) { const int n = (lane >> 3) + 8 * j; const LAS float* s = scr + (8 * c) * 33 + n;
        v4u o; o.x = pk2(s[0 * 33], s[1 * 33]); o.y = pk2(s[2 * 33], s[3 * 33]); o.z = pk2(s[4 * 33], s[5 * 33]); o.w = pk2(s[6 * 33], s[7 * 33]);
        if (NTS) __builtin_nontemporal_store(o, (v4u*)(d.WT + (size_t)(d.drow0 + n) * d.K + d.k0 + 8 * c)); else *(v4u*)(d.WT + (size_t)(d.drow0 + n) * d.K + d.k0 + 8 * c) = o; }
    LDS_WAIT(); asm volatile("" ::: "memory");
}
template <int SEL> __device__ __forceinline__ void tp_decode(const Args& a, int it, TpDesc& d) {
    unsigned char* ws = a.ws;
    if (SEL == 0) { const int nblk = INW / 32, kb = it / nblk, nb = it % nblk, n0 = 32 * nb; d = TpDesc{a.in[I_WIN], (bf16*)(ws + WS_WIN), a.in[I_N1G], DM, INW, n0 < 5536 ? n0 : n0 + 96, 64 * kb, n0}; }
    else if (SEL == 3) { constexpr int I_PA = (SGW / 64) * (DM / 32), I_PB = I_PA; int r = it;
        if (r < I_PA) { const int nblk = DM / 32, kb = r / nblk, nb = r % nblk; d = TpDesc{a.in[I_WPA], (bf16*)(ws + WS_WPA), nullptr, SGW, DM, 32 * nb, 64 * kb, 32 * nb}; return; } r -= I_PA;
        if (r < I_PB) { const int nblk = DM / 32, kb = r / nblk, nb = r % nblk; d = TpDesc{a.in[I_WPB], (bf16*)(ws + WS_WPB), nullptr, RWW, DM, 32 * nb, 64 * kb, 32 * nb}; return; } r -= I_PB;
        { const int nblk = DM / 32, kb = r / nblk, nb = r % nblk; d = TpDesc{a.in[I_WOUT], (bf16*)(ws + WS_WOUT), nullptr, DM, DM, 32 * nb, 64 * kb, 32 * nb}; } }
    else if (SEL == 1) { constexpr int I_G = (DM / 64) * (DFF / 32); int r = it; const bool up = r >= I_G; if (up) r -= I_G; const int nblk = DFF / 32, kb = r / nblk, nb = r % nblk;
        d = TpDesc{up ? a.in[I_WUP] : a.in[I_WGATE], (bf16*)(ws + (up ? WS_WU : WS_WG)), a.in[I_N2G], DM, DFF, 32 * nb, 64 * kb, 32 * nb}; }
    else { const int nblk = DM / 32, kb = it / nblk, nb = it % nblk; d = TpDesc{a.in[I_WDOWN], (bf16*)(ws + WS_WD), nullptr, DFF, DM, 32 * nb, 64 * kb, 32 * nb}; }
}
template <int SEL> __device__ __forceinline__ void tp_run(const Args& a, LAS float* scr, int lane, int first, int end, int step) {
    float va[32], sa[32], vb[32], sb[32]; TpDesc da, db;
    int it = first; if (it >= end) return;
    tp_decode<SEL>(a, it, da); tp_load(da, lane, va, sa);
    for (;;) {
        const int n1 = it + step; const bool h1 = n1 < end;
        if (h1) { tp_decode<SEL>(a, n1, db); tp_load(db, lane, vb, sb); }
        tp_store<SEL == 2>(da, scr, lane, va, sa);
        if (!h1) break;
        it = n1 + step; const bool h2 = it < end;
        if (h2) { tp_decode<SEL>(a, it, da); tp_load(da, lane, va, sa); }
        tp_store<SEL == 2>(db, scr, lane, vb, sb);
        if (!h2) break;
    }
}
__device__ __forceinline__ void phase_ffn_weights(const Args& a, LAS unsigned char* lds, int G) {
    const int tid = threadIdx.x, lane = tid & 63, wave = tid >> 6;
    constexpr int I_G = (DM / 64) * (DFF / 32);
    tp_run<1>(a, (LAS float*)(lds + wave * 16384), lane, blockIdx.x * NWAVES + wave, I_G, G * NWAVES);
}
__device__ __forceinline__ void convert_wup_tail(const Args& a, LAS unsigned char* lds, int nb_, int b0_) {
    const int tid = threadIdx.x, lane = tid & 63, wave = tid >> 6;
    constexpr int I_G = (DM / 64) * (DFF / 32);
    tp_run<1>(a, (LAS float*)(lds + wave * 16384), lane, I_G + ((int)blockIdx.x - b0_) * NWAVES + wave, 2 * I_G, nb_ * NWAVES);
}
__device__ __forceinline__ void convert_wdown_half(const Args& a, LAS unsigned char* lds, int half, int nb_, int b0_) {
    const int tid = threadIdx.x, lane = tid & 63, wave = tid >> 6;
    constexpr int I_D = (DFF / 64) * (DM / 32);
    if (half < 0) tp_run<2>(a, (LAS float*)(lds + wave * 16384), lane, ((int)blockIdx.x - b0_) * NWAVES + wave, I_D, nb_ * NWAVES);
    else tp_run<2>(a, (LAS float*)(lds + wave * 16384), lane, half * (I_D / 2) + ((int)blockIdx.x - b0_) * NWAVES + wave, (half + 1) * (I_D / 2), nb_ * NWAVES);
}
__device__ __forceinline__ void convert_small_weights(const Args& a, LAS unsigned char* lds, int nb_, int b0_) {
    const int tid = threadIdx.x, lane = tid & 63, wave = tid >> 6; unsigned char* ws = a.ws; const int G = nb_;
    tp_run<3>(a, (LAS float*)(lds + wave * 16384), lane, ((int)blockIdx.x - b0_) * NWAVES + wave, 2 * (SGW / 64) * (DM / 32) + (DM / 64) * (DM / 32), nb_ * NWAVES);
    { bf16* w2t = (bf16*)(ws + WS_W2T); const int gt_ = ((int)blockIdx.x - b0_) * NTHR + tid, nt_ = G * NTHR;
      for (int base = gt_; base < 416 * RWW; base += 4 * nt_) { float v[4];
#pragma unroll
          for (int u = 0; u < 4; ++u) { const int idx = base + u * nt_; v[u] = 0.f; if (idx < 416 * RWW) { const int j = idx >> 10, c = idx & 1023;
              v[u] = j < 64 ? a.in[I_W2F][(size_t)j * RWW + c] : j < 128 ? a.in[I_W2B][(size_t)(j - 64) * RWW + c] : j < 192 ? a.in[I_A2F][(size_t)(j - 128) * RWW + c] : j < 256 ? a.in[I_A2B][(size_t)(j - 192) * RWW + c] : a.in[I_G2][(size_t)(j - 256) * RWW + c]; } }
#pragma unroll
          for (int u = 0; u < 4; ++u) { const int idx = base + u * nt_; if (idx < 416 * RWW) { const int j = idx >> 10, c = idx & 1023;
              w2t[((size_t)((c >> 5) * 26 + (j >> 4)) * 64 + ((j >> 3) & 1) * 32 + (c & 31)) * 8 + (j & 7)] = (bf16)f2bf(v[u]); } } } }
}
__device__ __forceinline__ void phase_prologue(const Args& a, LAS unsigned char* lds, int G) {
    const int tid = threadIdx.x, lane = tid & 63, wave = tid >> 6;
    LAS float* scr = (LAS float*)(lds + wave * 16384);
    const int gw = blockIdx.x * NWAVES + wave, NGW = G * NWAVES;
    unsigned char* ws = a.ws;
    tp_run<0>(a, scr, lane, gw, (DM / 64) * (INW / 32), NGW);
    { v4u* z = (v4u*)((bf16*)(ws + WS_WIN) + (size_t)5536 * DM); const int nz = 96 * DM * 2 / 16;
      for (int i = blockIdx.x * NTHR + tid; i < nz; i += G * NTHR) z[i] = (v4u){0u, 0u, 0u, 0u}; }
    const float* x = a.in[I_X]; bf16* xb = (bf16*)(ws + WS_XB); float* rstd1 = (float*)(ws + WS_RSTD1);
    for (int m = gw; m < MTOK; m += 2 * NGW) { const int m1 = m + NGW; const bool h1 = m1 < MTOK;
        const f32x4* xr0 = (const f32x4*)(x + (size_t)m * DM) + lane; const f32x4* xr1 = (const f32x4*)(x + (size_t)(h1 ? m1 : m) * DM) + lane; f32x4 v0[8], v1[8]; float s0 = 0.f, s1 = 0.f;
#pragma unroll
        for (int j = 0; j < 8; ++j) { v0[j] = __builtin_nontemporal_load(xr0 + 64 * j); v1[j] = __builtin_nontemporal_load(xr1 + 64 * j); }
#pragma unroll
        for (int j = 0; j < 8; ++j) { s0 += (v0[j].x * v0[j].x + v0[j].y * v0[j].y) + (v0[j].z * v0[j].z + v0[j].w * v0[j].w); s1 += (v1[j].x * v1[j].x + v1[j].y * v1[j].y) + (v1[j].z * v1[j].z + v1[j].w * v1[j].w); }
        s0 = wave_sum(s0); s1 = wave_sum(s1);
        if (lane == 0) { rstd1[m] = 1.0f / sqrtf(s0 * (1.0f / DM) + NORM_EPS); if (h1) rstd1[m1] = 1.0f / sqrtf(s1 * (1.0f / DM) + NORM_EPS); }
        unsigned long long* o0 = (unsigned long long*)(xb + (size_t)m * DM) + lane; unsigned long long* o1 = (unsigned long long*)(xb + (size_t)(h1 ? m1 : m) * DM) + lane;
#pragma unroll
        for (int j = 0; j < 8; ++j) { o0[64 * j] = (unsigned long long)pk2(v0[j].x, v0[j].y) | ((unsigned long long)pk2(v0[j].z, v0[j].w) << 32);
            if (h1) o1[64 * j] = (unsigned long long)pk2(v1[j].x, v1[j].y) | ((unsigned long long)pk2(v1[j].z, v1[j].w) << 32); }
    }
}

typedef short bf16x8_t __attribute__((ext_vector_type(8)));
typedef float f32x16 __attribute__((ext_vector_type(16)));
constexpr int SGP = 136;
__device__ __forceinline__ void phase_sgu(const Args& a, LAS unsigned char* lds, int G) {
    const int tid = threadIdx.x, lane = tid & 63, wave = tid >> 6;
    LAS bf16* wimg = (LAS bf16*)lds;
    LAS bf16* vt = (LAS bf16*)(lds + 128 * SGP * 2);
    LAS float* mu = (LAS float*)(lds + 2 * 128 * SGP * 2);
    LAS float* rs = mu + 128;
    const bf16* U = (const bf16*)(a.ws + WS_U); const bf16* VG = (const bf16*)(a.ws + WS_VG); bf16* YA = (bf16*)(a.ws + WS_YA);
    const float* lng = a.in[I_SLNG]; const float* lnb = a.in[I_SLNB]; const float* sw = a.in[I_SW]; const float* sb = a.in[I_SB];
    unsigned long long sq0 = 0, sq1 = 0, sq2 = 0, sql = 0;
#define SGT(ACC) do { if (PROBE_TA != 0) { const unsigned long long n_ = __builtin_amdgcn_s_memrealtime(); ACC += n_ - sql; sql = n_; } } while (0)
    for (int item = blockIdx.x; item < 512; item += G) {
        if (PROBE_TA != 0) sql = __builtin_amdgcn_s_memrealtime();
        const int bc = item >> 3, g = item & 7, m0 = bc * 128;
        v4u vraw[4];
#pragma unroll
        for (int q = 0; q < 4; ++q) { const int it2 = q * 8 + wave; const int j = (it2 & 1) * 64 + lane, dg = it2 >> 1; vraw[q] = *(const v4u*)(VG + (size_t)(m0 + j) * SGW + g * 128 + dg * 8); }
        if (tid < 128) { const f32x4* pp = (const f32x4*)((const float*)(a.ws + WS_PART) + (size_t)(m0 + tid) * 32); float s1 = 0.f, s2 = 0.f;
#pragma unroll
            for (int q = 0; q < 8; ++q) { const f32x4 v = pp[q]; s1 += v.x + v.z; s2 += v.y + v.w; }
            const float mean = s1 * (1.0f / SGW); const float var = fmaxf(s2 * (1.0f / SGW) - mean * mean, 0.f);
            mu[tid] = mean; rs[tid] = 1.0f / sqrtf(var + LN_EPS); }
#pragma unroll
        for (int q = 0; q < 8; ++q) { const int idx = q * NTHR + tid; const int i = idx >> 5, j4 = (idx & 31) * 4; const f32x4 w4 = *(const f32x4*)(sw + (size_t)g * 16384 + i * 128 + j4);
            v2u o; o.x = pk2(w4.x, w4.y); o.y = pk2(w4.z, w4.w); *(LAS v2u*)(wimg + i * SGP + j4) = o; }
        __syncthreads(); SGT(sq0);
#pragma unroll
        for (int q = 0; q < 4; ++q) { const int it2 = q * 8 + wave; const int j = (it2 & 1) * 64 + lane, dg = it2 >> 1; const int ch = g * 128 + dg * 8;
            const v4u raw = vraw[q]; const float mj = mu[j], rj = rs[j];
            const f32x4 g0 = *(const f32x4*)(lng + ch), g1 = *(const f32x4*)(lng + ch + 4), b0 = *(const f32x4*)(lnb + ch), b1 = *(const f32x4*)(lnb + ch + 4);
#pragma unroll
            for (int e = 0; e < 8; ++e) { const unsigned w = raw[e >> 1]; const float x = (e & 1) ? bfhi(w) : bflo(w); const float gg = e < 4 ? g0[e & 3] : g1[e & 3], bb = e < 4 ? b0[e & 3] : b1[e & 3];
                vt[(dg * 8 + e) * SGP + j] = (bf16)f2bf((x - mj) * rj * gg + bb); } }
        __syncthreads(); SGT(sq1);
        const int ti = wave >> 1, tj0 = (wave & 1) * 2, r31 = lane & 31, hh = lane >> 5;
        v4u upc[2][2];
#pragma unroll
        for (int tt = 0; tt < 2; ++tt)
#pragma unroll
            for (int q = 0; q < 2; ++q) { const int idx = lane + 64 * q; upc[tt][q] = *(const v4u*)(U + (size_t)(m0 + 32 * ti + (idx >> 2)) * SGW + g * 128 + 32 * (tj0 + tt) + 8 * (idx & 3)); }
        float sbv[16];
#pragma unroll
        for (int e = 0; e < 16; ++e) sbv[e] = sb[g * 128 + 32 * ti + (e & 3) + 8 * (e >> 2) + 4 * hh];
        f32x16 acc0, acc1;
#pragma unroll
        for (int e = 0; e < 16; ++e) { acc0[e] = 0.f; acc1[e] = 0.f; }
#pragma unroll
        for (int kk = 0; kk < 8; ++kk) {
            const bf16x8_t af = *(const LAS bf16x8_t*)(wimg + (32 * ti + r31) * SGP + 16 * kk + 8 * hh);
            const bf16x8_t b0 = *(const LAS bf16x8_t*)(vt + (32 * tj0 + r31) * SGP + 16 * kk + 8 * hh);
            const bf16x8_t b1 = *(const LAS bf16x8_t*)(vt + (32 * (tj0 + 1) + r31) * SGP + 16 * kk + 8 * hh);
            acc0 = __builtin_amdgcn_mfma_f32_32x32x16_bf16(af, b0, acc0, 0, 0, 0);
            acc1 = __builtin_amdgcn_mfma_f32_32x32x16_bf16(af, b1, acc1, 0, 0, 0); }
        LAS bf16* stg_ = (LAS bf16*)(lds + 2 * 128 * SGP * 2 + 1024 + wave * 2560);
#pragma unroll
        for (int tt = 0; tt < 2; ++tt) {
#pragma unroll
            for (int q = 0; q < 2; ++q) { const int idx = lane + 64 * q; *(LAS v4u*)(stg_ + (idx >> 2) * 40 + 8 * (idx & 3)) = upc[tt][q]; }
            asm volatile("s_waitcnt lgkmcnt(0)" ::: "memory");
            float uv[16];
#pragma unroll
            for (int e = 0; e < 16; ++e) uv[e] = bf2f(stg_[((e & 3) + 8 * (e >> 2) + 4 * hh) * 40 + r31]);
            asm volatile("s_waitcnt lgkmcnt(0)" ::: "memory");
#pragma unroll
            for (int e = 0; e < 16; ++e) { const float mixed = (tt ? acc1[e] : acc0[e]) + sbv[e]; stg_[((e & 3) + 8 * (e >> 2) + 4 * hh) * 40 + r31] = (bf16)f2bf(uv[e] * mixed); }
            asm volatile("s_waitcnt lgkmcnt(0)" ::: "memory");
#pragma unroll
            for (int q = 0; q < 2; ++q) { const int idx = lane + 64 * q; const v4u v = *(const LAS v4u*)(stg_ + (idx >> 2) * 40 + 8 * (idx & 3));
                *(v4u*)(YA + (size_t)(m0 + 32 * ti + (idx >> 2)) * SGW + g * 128 + 32 * (tj0 + tt) + 8 * (idx & 3)) = v; }
            asm volatile("s_waitcnt lgkmcnt(0)" ::: "memory"); }
        __syncthreads(); SGT(sq2);
    }
    if (PROBE_TA != 0 && blockIdx.x == 0 && tid == 0) { unsigned long long* st = (unsigned long long*)(a.ws + WS_CTL + 32768); st[28] = sq0; st[29] = sq1; st[30] = sq2; st[31] = 0; }
}

constexpr int PT = 32;
constexpr int LORA_K = 416;
constexpr int ACTP = 424;
__device__ __forceinline__ float ldbf(const bf16* base, unsigned byte_off) { return bf2f(*(const bf16*)((const char*)base + byte_off)); }
__device__ __forceinline__ void stbf(bf16* base, unsigned byte_off, float v) { *(bf16*)((char*)base + byte_off) = (bf16)f2bf(v); }
__device__ __forceinline__ float shift_mix(float fp, float fc, float fn, float mp, float mn) { return fc + mp * (fp - fc) + mn * (fn - fc); }
constexpr int PRP = 40;
constexpr int PREP_WAVE_LDS = (3 * 34 + 8 * 8) * PRP * 2;
__device__ __forceinline__ void phase_prep(const Args& a, LAS unsigned char* lds, int G) {
    const int tid = threadIdx.x, lane = tid & 63, wave = tid >> 6, r31 = lane & 31, hh = lane >> 5;
    LAS bf16* act = (LAS bf16*)lds;
    LAS bf16* inb = (LAS bf16*)(lds + PT * ACTP * 2 + wave * PREP_WAVE_LDS);
    LAS bf16* outb = inb + 3 * 34 * PRP;
    unsigned char* ws = a.ws;
    const bf16* FT = (const bf16*)(ws + WS_FEAT); const bf16* W2T = (const bf16*)(ws + WS_W2T);
    bf16 *SR = (bf16*)(ws + WS_SR), *SK = (bf16*)(ws + WS_SK), *SV = (bf16*)(ws + WS_SV), *GG = (bf16*)(ws + WS_GG);
    bf16 *WF = (bf16*)((unsigned char*)a.out + DO_WF), *AF = (bf16*)((unsigned char*)a.out + DO_AF), *WB = (bf16*)((unsigned char*)a.out + DO_WB), *AB = (bf16*)((unsigned char*)a.out + DO_AB);
    const float *mup = a.in[I_MUP], *mun = a.in[I_MUN];
    unsigned long long pt0 = 0, pt1 = 0, pt2 = 0, ptl = 0;
    for (int tile = blockIdx.x; tile < MTOK / PT; tile += G) {
        const int m0 = tile * PT;
        if (PROBE_TA != 0) ptl = __builtin_amdgcn_s_memrealtime();
        const bool has_prev = (m0 & (SEQ - 1)) != 0, has_next = ((m0 + PT) & (SEQ - 1)) != 0;
        v4u stg[7];
#define PREP_STG_LOAD(C0) do { _Pragma("unroll") for (int q = 0; q < 7; ++q) { const int idx = lane + 64 * q; stg[q] = (v4u){0u, 0u, 0u, 0u}; if (idx < 408) { const int arr = idx / 136, rem = idx - arr * 136, row = rem >> 2, p = rem & 3; \
                    const bool ok = !((row == 0 && !has_prev) || (row == 33 && !has_next)); if (ok) stg[q] = *(const v4u*)(FT + (size_t)(m0 - 1 + row) * FEATP + arr * 1024 + (C0) + p * 8); } } } while (0)
        PREP_STG_LOAD(wave * 128);
        { LAS bf16* fst = (LAS bf16*)(lds + PT * ACTP * 2);
          const bool hp_ = (m0 & (SEQ - 1)) != 0, hn_ = ((m0 + PT) & (SEQ - 1)) != 0;
          for (int idx = tid; idx < 34 * 52; idx += NTHR) { const int row = idx / 52, p = idx - row * 52; const bool ok = !((row == 0 && !hp_) || (row == 33 && !hn_));
              v4u v = (v4u){0u, 0u, 0u, 0u}; if (ok) v = *(const v4u*)(FT + (size_t)(m0 - 1 + row) * FEATP + 3072 + p * 8);
              *(LAS v4u*)(fst + row * ACTP + p * 8) = v; }
          __syncthreads();
          if (tid < LORA_K) { const int j = tid; const float mp = mup[3072 + j], mn = mun[3072 + j]; float fp = bf2f(fst[j]), fc = bf2f(fst[ACTP + j]);
#pragma unroll 8
              for (int t = 0; t < PT; ++t) { const float fn = bf2f(fst[(t + 2) * ACTP + j]); float xs = shift_mix(fp, fc, fn, mp, mn);
                  if (j < 128) xs = 1.0f - 2.0f * __builtin_amdgcn_rcpf(1.0f + __builtin_amdgcn_exp2f(2.88539008178f * xs)); else if (j >= 256) xs = sigmoidf_(xs);
                  act[t * ACTP + j] = (bf16)f2bf(xs); fp = fc; fc = fn; } } }
        __syncthreads();
#pragma unroll 1
        for (int ct = 0; ct < 4; ++ct) { const int c0 = wave * 128 + ct * 32, c = c0 + r31;
            const float w0f = a.in[I_W0F][c], w0b = a.in[I_W0B][c], a0f = a.in[I_A0F][c], a0b = a.in[I_A0B][c];
            const float mpr = mup[c], mnr = mun[c], mpk = mup[1024 + c], mnk = mun[1024 + c], mpv = mup[2048 + c], mnv = mun[2048 + c];
            const bf16* brow = W2T + ((size_t)(c0 >> 5) * 26 * 64 + lane) * 8; const LAS bf16* arow = act + r31 * ACTP + 8 * hh;
            bf16x8_t bq[13];
#pragma unroll
            for (int u = 0; u < 13; ++u) bq[u] = *(const bf16x8_t*)(brow + u * 512);
            asm volatile("" ::: "memory");
            f32x16 cwf, cwb, caf, cab, cg;
#pragma unroll
            for (int e = 0; e < 16; ++e) { cwf[e] = 0.f; cwb[e] = 0.f; caf[e] = 0.f; cab[e] = 0.f; cg[e] = 0.f; }
#pragma unroll
            for (int half = 0; half < 2; ++half) {
                if (half == 1) {
#pragma unroll
                    for (int u = 0; u < 13; ++u) bq[u] = *(const bf16x8_t*)(brow + (13 + u) * 512); }
#pragma unroll
                for (int u = 0; u < 13; ++u) { const int kk = 13 * half + u; const bf16x8_t af_ = *(const LAS bf16x8_t*)(arow + 16 * kk); const bf16x8_t bf_ = bq[u];
                    if (kk < 4) cwf = __builtin_amdgcn_mfma_f32_32x32x16_bf16(af_, bf_, cwf, 0, 0, 0);
                    else if (kk < 8) cwb = __builtin_amdgcn_mfma_f32_32x32x16_bf16(af_, bf_, cwb, 0, 0, 0);
                    else if (kk < 12) caf = __builtin_amdgcn_mfma_f32_32x32x16_bf16(af_, bf_, caf, 0, 0, 0);
                    else if (kk < 16) cab = __builtin_amdgcn_mfma_f32_32x32x16_bf16(af_, bf_, cab, 0, 0, 0);
                    else cg = __builtin_amdgcn_mfma_f32_32x32x16_bf16(af_, bf_, cg, 0, 0, 0); } }
#pragma unroll
            for (int q = 0; q < 7; ++q) { const int idx = lane + 64 * q; if (idx < 408) { const int arr = idx / 136, rem = idx - arr * 136, row = rem >> 2, p = rem & 3; *(LAS v4u*)(inb + (arr * 34 + row) * PRP + p * 8) = stg[q]; } }
            PREP_STG_LOAD(wave * 128 + (ct < 3 ? ct + 1 : 3) * 32);
            if (PROBE_TA != 0) { asm volatile("s_waitcnt vmcnt(0) lgkmcnt(0)" ::: "memory"); const unsigned long long n_ = __builtin_amdgcn_s_memrealtime(); pt1 += n_ - ptl; ptl = n_; }
            asm volatile("s_waitcnt lgkmcnt(0)" ::: "memory");
#pragma unroll
            for (int gq = 0; gq < 4; ++gq) { const int t0 = 8 * gq + 4 * hh; float fr[6], fk[6], fv[6];
#pragma unroll
                for (int u = 0; u < 6; ++u) { const int row = t0 + u; fr[u] = bf2f(inb[row * PRP + r31]); fk[u] = bf2f(inb[(34 + row) * PRP + r31]); fv[u] = bf2f(inb[(68 + row) * PRP + r31]); }
                float o8[8][4];
#pragma unroll
                for (int u = 0; u < 4; ++u) { const int e = 4 * gq + u;
                    const float xr = shift_mix(fr[u], fr[u + 1], fr[u + 2], mpr, mnr), xk = shift_mix(fk[u], fk[u + 1], fk[u + 2], mpk, mnk), xv = shift_mix(fv[u], fv[u + 1], fv[u + 2], mpv, mnv);
                    const float ef = 0.60653066f * sigmoidf_(w0f + cwf[e]), eb = 0.60653066f * sigmoidf_(w0b + cwb[e]);
                    const float omwf = 1.0f - __builtin_amdgcn_exp2f(-1.44269504089f * ef), omwb = 1.0f - __builtin_amdgcn_exp2f(-1.44269504089f * eb);
                    const float af = sigmoidf_(a0f + caf[e]), ab = sigmoidf_(a0b + cab[e]);
                    o8[0][u] = xr; o8[1][u] = xk; o8[2][u] = xv; o8[3][u] = omwf; o8[4][u] = af; o8[5][u] = omwb; o8[6][u] = ab; o8[7][u] = cg[e]; }
                const unsigned ooff = bl_off(m0 >> 12, c0 >> 6, ((m0 & (SEQ - 1)) >> 3) + gq, (c0 & 63) + r31) + 4 * hh;
#pragma unroll
                for (int j = 0; j < 8; ++j) { bf16* dst = j == 0 ? SR : j == 1 ? SK : j == 2 ? SV : j == 3 ? WF : j == 4 ? AF : j == 5 ? WB : j == 6 ? AB : GG;
                    v2u w; w.x = pk2(o8[j][0], o8[j][1]); w.y = pk2(o8[j][2], o8[j][3]); *(v2u*)(dst + ooff) = w; } }
            if (PROBE_TA != 0) { const unsigned long long n_ = __builtin_amdgcn_s_memrealtime(); pt2 += n_ - ptl; ptl = n_; }
        }
        __syncthreads();
    }
    if (PROBE_TA != 0 && blockIdx.x == 0 && tid == 0) { unsigned long long* st = (unsigned long long*)(a.ws + WS_CTL + 32768); st[24] = pt0; st[25] = pt1; st[26] = pt2; st[27] = 0; }
}

constexpr int CL = 64, IP = 72, IMG_BYTES = 64 * IP * 2;
enum { SL_KH = 0, SL_KT = 1, SL_BT = 2, SL_RH = 3, SL_KHT = 4, SL_KBT = 5, SL_BBT = 6, SL_VT = 7, SL_A1T = 8, SL_A2T = 9, SL_A3 = 10, SL_A4 = 11, SL_DG = 12, SL_DGT = 13, SL_T = 14,
       SL_M = 0, SL_MT = 1, SL_M2 = 2, SL_Q = 8, SL_U = 12, SL_KQT = 13, SL_VNT = 0 };
constexpr int S1_MISC = 15 * IMG_BYTES;
__device__ __forceinline__ void mm_tile(f32x16& acc, const LAS bf16* A, int am0, const LAS bf16* B, int bn0, int r31, int hh) {
#pragma unroll
    for (int ks = 0; ks < 4; ++ks) { const bf16x8_t af = *(const LAS bf16x8_t*)(A + (am0 + r31) * IP + 16 * ks + 8 * hh); const bf16x8_t bq = *(const LAS bf16x8_t*)(B + (bn0 + r31) * IP + 16 * ks + 8 * hh);
        acc = __builtin_amdgcn_mfma_f32_32x32x16_bf16(af, bq, acc, 0, 0, 0); }
}
__device__ __forceinline__ void st_tileT(LAS bf16* img, const f32x16& acc, int m0, int n0, int r31, int hh) {
#pragma unroll
    for (int g = 0; g < 4; ++g) { v2u o; o.x = pk2(acc[4 * g], acc[4 * g + 1]); o.y = pk2(acc[4 * g + 2], acc[4 * g + 3]); *(LAS v2u*)(img + (n0 + r31) * IP + m0 + 8 * g + 4 * hh) = o; }
}
__device__ __forceinline__ void st_tileN(LAS bf16* img, const f32x16& acc, int m0, int n0, int r31, int hh) {
#pragma unroll
    for (int e = 0; e < 16; ++e) img[(m0 + crow(e, hh)) * IP + n0 + r31] = (bf16)f2bf(acc[e]);
}
__device__ __forceinline__ void st_tileT_perm(bf16* g, const f32x16& acc, int m0, int n0, int r31, int hh) {
#pragma unroll
    for (int p = 0; p < 2; ++p) { v4u o; o.x = pk2(acc[8 * p], acc[8 * p + 1]); o.y = pk2(acc[8 * p + 2], acc[8 * p + 3]); o.z = pk2(acc[8 * p + 4], acc[8 * p + 5]); o.w = pk2(acc[8 * p + 6], acc[8 * p + 7]);
        *(v4u*)(g + (size_t)(n0 + r31) * 64 + m0 + 16 * p + 8 * hh) = o; }
}
__device__ __forceinline__ void st_dump(bf16* g, const f32x16& acc, int mi, int ni, int lane) {
    v4u o0, o1; o0.x = pk2(acc[0], acc[1]); o0.y = pk2(acc[2], acc[3]); o0.z = pk2(acc[4], acc[5]); o0.w = pk2(acc[6], acc[7]);
    o1.x = pk2(acc[8], acc[9]); o1.y = pk2(acc[10], acc[11]); o1.z = pk2(acc[12], acc[13]); o1.w = pk2(acc[14], acc[15]);
    v4u* p = (v4u*)(g + ((size_t)(mi * 2 + ni) * 64 + lane) * 16); p[0] = o0; p[1] = o1;
}
__device__ __forceinline__ void zero16(f32x16& a) {
#pragma unroll
    for (int e = 0; e < 16; ++e) a[e] = 0.f;
}

__device__ __forceinline__ void phase_chunk_prep(const Args& a, LAS unsigned char* lds, int G) {
    const int tid = threadIdx.x, lane = tid & 63, wave = __builtin_amdgcn_readfirstlane(tid >> 6), r31 = lane & 31, hh = lane >> 5;
    unsigned char* ws = a.ws;
    const bf16 *SR = (const bf16*)(ws + WS_SR), *SK = (const bf16*)(ws + WS_SK), *SV = (const bf16*)(ws + WS_SV), *SKK = (const bf16*)(ws + WS_SKK);
    bf16 *CP = (bf16*)(ws + WS_CP), *CD = (bf16*)(ws + WS_CD), *CRQ = (bf16*)(ws + WS_CRQ), *COI = (bf16*)(ws + WS_COI);
#define SLOT(i) ((LAS bf16*)(lds + (i) * IMG_BYTES))
    LAS float* tot = (LAS float*)(lds + S1_MISC);
    LAS float* glv = tot + 512;
    const int mi = (wave >> 1) & 1, ni = wave & 1;
    unsigned long long tacc0 = 0, tacc1 = 0, tacc2 = 0, tacc3 = 0, tlast = 0;
#define S1T(ACC) do { if (PROBE_TA != 0) { const unsigned long long now_ = __builtin_amdgcn_s_memrealtime(); ACC += now_ - tlast; tlast = now_; } } while (0)
    v4u rawv[5];
    float kac_n = 0.f, kkc_n = 0.f;
#define S1_LOAD(IT) do { const int sid_ = (IT) >> 6, cs_ = (IT) & 63, dir_ = sid_ & 1, h_ = (sid_ >> 1) & 15, b_ = sid_ >> 5; const int tbase_ = dir_ ? (SEQ - CL * (cs_ + 1)) : CL * cs_; \
        const bf16* OMW_ = (const bf16*)((unsigned char*)a.out + (dir_ ? DO_WB : DO_WF)); const bf16* AA_ = (const bf16*)((unsigned char*)a.out + (dir_ ? DO_AB : DO_AF)); \
        const unsigned o = bl_off(b_, h_, (tbase_ >> 3) + (dir_ ? 7 - wave : wave), lane); \
        rawv[0] = *(const v4u*)(SR + o); rawv[1] = *(const v4u*)(SK + o); rawv[2] = *(const v4u*)(SV + o); rawv[3] = *(const v4u*)(OMW_ + o); rawv[4] = *(const v4u*)(AA_ + o); \
        kac_n = a.in[I_KA][h_ * 64 + lane]; kkc_n = a.in[I_KK][h_ * 64 + lane]; } while (0)
    if ((int)blockIdx.x < 4096) S1_LOAD(blockIdx.x);
    for (int item = blockIdx.x; item < 4096; item += G) {
        const int sid = item >> 6, h = (sid >> 1) & 15, dir = sid & 1;
        if (dir) {
#pragma unroll
            for (int q = 0; q < 5; ++q) { const v4u t_ = rawv[q]; rawv[q] = (v4u){__builtin_rotateleft32(t_.w, 16), __builtin_rotateleft32(t_.z, 16), __builtin_rotateleft32(t_.y, 16), __builtin_rotateleft32(t_.x, 16)}; } }
        unsigned short raw[6][8];
#pragma unroll
        for (int q = 0; q < 5; ++q) { const int qa = q < 3 ? q : q + 1;
#pragma unroll
            for (int i = 0; i < 8; ++i) { const unsigned w_ = rawv[q][i >> 1]; raw[qa][i] = (unsigned short)((i & 1) ? (w_ >> 16) : (w_ & 0xffffu)); } }
        if (PROBE_TA != 0) tlast = __builtin_amdgcn_s_memrealtime();
        { const int k = lane, tb = wave; const float kac = kac_n;
          float fr[8], fkd[8], fv[8], fkk[8], fb[8], e2[8];
          const float kkc = kkc_n;
          float k2v[8], ssq[8];
#pragma unroll
          for (int i = 0; i < 8; ++i) { k2v[i] = bf2f(raw[1][i]) * kkc; ssq[i] = wave_sum(k2v[i] * k2v[i]); }
#pragma unroll
          for (int i = 0; i < 8; ++i) { const float r_ = bf2f(raw[0][i]), k_ = bf2f(raw[1][i]), v_ = bf2f(raw[2][i]), kk_ = k2v[i] * (1.0f / sqrtf(fmaxf(ssq[i], 1e-24f))), om = bf2f(raw[4][i]), a_ = bf2f(raw[5][i]);
              fr[i] = r_; fv[i] = v_; fkk[i] = kk_; fkd[i] = k_ * (1.0f + (a_ - 1.0f) * kac); fb[i] = kk_ * a_; e2[i] = 1.0f - om; }
          float g[8]; g[0] = e2[0];
#pragma unroll
          for (int i = 1; i < 8; ++i) g[i] = g[i - 1] * e2[i];
          tot[tb * 64 + k] = -__builtin_amdgcn_logf(g[7]);
          for (int i = tid; i < 2 * IMG_BYTES / 16; i += NTHR) ((LAS v4u*)SLOT(SL_DG))[i] = (v4u){0u, 0u, 0u, 0u};
          __syncthreads(); S1T(tacc0);
          float pre = 0.f, gl = 0.f;
#pragma unroll
          for (int q = 0; q < 8; ++q) { const float tq = tot[q * 64 + k]; gl += tq; if (q < tb) pre += tq; }
          const float xm0 = __builtin_amdgcn_exp2f(-pre), glx = __builtin_amdgcn_exp2f(-gl);
          if (tb == 0) glv[k] = glx;
          float pkht[8], pkbt[8], pbbt[8];
#pragma unroll
          for (int i = 0; i < 8; ++i) { const int t = 8 * tb + i;
              const float xg = xm0 * g[i], xm = i == 0 ? xm0 : xm0 * g[i - 1], xp = __builtin_amdgcn_rcpf(xg), xl = glx * xp;
              const float kh = fkk[i] * xm, rh = fr[i] * xg, kt = fkd[i] * xp, bt = fb[i] * xp, kb = fkd[i] * xl, bb = -fb[i] * xl;
              SLOT(SL_KH)[t * IP + k] = (bf16)f2bf(kh); SLOT(SL_RH)[t * IP + k] = (bf16)f2bf(rh); SLOT(SL_KT)[t * IP + k] = (bf16)f2bf(kt); SLOT(SL_BT)[t * IP + k] = (bf16)f2bf(bt);
              pkht[i] = kh; pkbt[i] = kb; pbbt[i] = bb; }
          v4u w;
          w.x = pk2(pkht[0], pkht[1]); w.y = pk2(pkht[2], pkht[3]); w.z = pk2(pkht[4], pkht[5]); w.w = pk2(pkht[6], pkht[7]); *(LAS v4u*)(SLOT(SL_KHT) + k * IP + 8 * tb) = w;
          w.x = pk2(pkbt[0], pkbt[1]); w.y = pk2(pkbt[2], pkbt[3]); w.z = pk2(pkbt[4], pkbt[5]); w.w = pk2(pkbt[6], pkbt[7]); *(LAS v4u*)(SLOT(SL_KBT) + k * IP + 8 * tb) = w;
          w.x = pk2(pbbt[0], pbbt[1]); w.y = pk2(pbbt[2], pbbt[3]); w.z = pk2(pbbt[4], pbbt[5]); w.w = pk2(pbbt[6], pbbt[7]); *(LAS v4u*)(SLOT(SL_BBT) + k * IP + 8 * tb) = w;
          w.x = (unsigned)raw[2][0] | ((unsigned)raw[2][1] << 16); w.y = (unsigned)raw[2][2] | ((unsigned)raw[2][3] << 16); w.z = (unsigned)raw[2][4] | ((unsigned)raw[2][5] << 16); w.w = (unsigned)raw[2][6] | ((unsigned)raw[2][7] << 16); *(LAS v4u*)(SLOT(SL_VT) + k * IP + 8 * tb) = w;
        }
        __syncthreads(); S1T(tacc1);
        if (item + G < 4096) S1_LOAD(item + G);
        { const int prod = wave >> 2; f32x16 acc; zero16(acc); mm_tile(acc, SLOT(SL_KH), 32 * mi, prod ? SLOT(SL_KT) : SLOT(SL_BT), 32 * ni, r31, hh);
          const int n = 32 * ni + r31;
#pragma unroll
          for (int e = 0; e < 16; ++e) { const int m = 32 * mi + crow(e, hh); if (!(n < m)) acc[e] = 0.f; }
          st_tileT(SLOT(SL_A1T + prod), acc, 32 * mi, 32 * ni, r31, hh); }
        __syncthreads(); S1T(tacc2);
        if (wave == 0) { const int bi = lane >> 4, c = lane & 15; float X[16];
#pragma unroll
            for (int t = 0; t < 16; ++t) X[t] = (t == c) ? 1.f : 0.f;
#pragma unroll
            for (int s = 0; s < 15; ++s) { const LAS bf16* rowp = SLOT(SL_A1T) + (16 * bi + s) * IP + 16 * bi;
                const v4u q0 = *(const LAS v4u*)rowp, q1 = *(const LAS v4u*)(rowp + 8); const float xs = X[s];
#pragma unroll
                for (int t = s + 1; t < 16; ++t) { const unsigned wv = t < 8 ? q0[t >> 1] : q1[(t - 8) >> 1]; const float nv = (t & 1) ? bfhi(wv) : bflo(wv); X[t] -= nv * xs; } }
#pragma unroll
            for (int t = 0; t < 16; ++t) SLOT(SL_DG)[(16 * bi + t) * IP + 16 * bi + c] = (bf16)f2bf(X[t]);
            v4u w0, w1; w0.x = pk2(X[0], X[1]); w0.y = pk2(X[2], X[3]); w0.z = pk2(X[4], X[5]); w0.w = pk2(X[6], X[7]); w1.x = pk2(X[8], X[9]); w1.y = pk2(X[10], X[11]); w1.z = pk2(X[12], X[13]); w1.w = pk2(X[14], X[15]);
            LAS v4u* dp = (LAS v4u*)(SLOT(SL_DGT) + (16 * bi + c) * IP + 16 * bi); dp[0] = w0; dp[1] = w1; }
        else {
#pragma unroll 1
            for (int tl = wave - 1; tl < 8; tl += 7) { const int prod = tl >> 2, gm = (tl >> 1) & 1, gn = tl & 1;
                f32x16 acc; zero16(acc); mm_tile(acc, prod ? SLOT(SL_KT) : SLOT(SL_BT), 32 * gm, SLOT(SL_RH), 32 * gn, r31, hh);
                const int n = 32 * gn + r31;
#pragma unroll
                for (int e = 0; e < 16; ++e) { const int m = 32 * gm + crow(e, hh); acc[e] = (m <= n) ? (prod ? acc[e] : -acc[e]) : 0.f; }
                st_tileT(SLOT(SL_A3 + prod), acc, 32 * gm, 32 * gn, r31, hh); } }
        __syncthreads(); S1T(tacc3);
        f32x16 c2;
        if (wave < 4) { f32x16 acc; zero16(acc); mm_tile(acc, SLOT(SL_A1T), 32 * mi, SLOT(SL_DG), 32 * ni, r31, hh);
            const int n = 32 * ni + r31;
#pragma unroll
            for (int e = 0; e < 16; ++e) { const int m = 32 * mi + crow(e, hh); if ((m >> 4) == (n >> 4)) acc[e] = 0.f; }
            st_tileT(SLOT(SL_M), acc, 32 * mi, 32 * ni, r31, hh); st_tileN(SLOT(SL_MT), acc, 32 * mi, 32 * ni, r31, hh); }
        __syncthreads();
        if (wave < 4) { zero16(c2); mm_tile(c2, SLOT(SL_MT), 32 * mi, SLOT(SL_M), 32 * ni, r31, hh); st_tileT(SLOT(SL_M2), c2, 32 * mi, 32 * ni, r31, hh); }
        __syncthreads();
        if (wave < 4) { f32x16 c3; zero16(c3); mm_tile(c3, SLOT(SL_MT), 32 * mi, SLOT(SL_M2), 32 * ni, r31, hh);
            const int n = 32 * ni + r31;
#pragma unroll
            for (int g = 0; g < 4; ++g) { const v2u mw = *(const LAS v2u*)(SLOT(SL_M) + n * IP + 32 * mi + 8 * g + 4 * hh);
#pragma unroll
                for (int i = 0; i < 4; ++i) { const int e = 4 * g + i; const int m = 32 * mi + crow(e, hh); const unsigned wv = mw[i >> 1]; const float mt = (i & 1) ? bfhi(wv) : bflo(wv);
                    c3[e] = ((m == n) ? 1.f : 0.f) - mt + c2[e] - c3[e]; } }
            st_tileT(SLOT(SL_Q), c3, 32 * mi, 32 * ni, r31, hh); }
        __syncthreads();
        if (wave < 4) { f32x16 acc; zero16(acc); mm_tile(acc, SLOT(SL_DGT), 32 * mi, SLOT(SL_Q), 32 * ni, r31, hh); st_tileT(SLOT(SL_T), acc, 32 * mi, 32 * ni, r31, hh); }
        __syncthreads(); S1T(tacc3);
        { f32x16 acc; zero16(acc);
          if (wave < 4) { mm_tile(acc, SLOT(SL_T), 32 * mi, SLOT(SL_KHT), 32 * ni, r31, hh); st_tileT(SLOT(SL_KQT), acc, 32 * mi, 32 * ni, r31, hh); }
          else { mm_tile(acc, SLOT(SL_A2T), 32 * mi, SLOT(SL_T), 32 * ni, r31, hh); st_tileT(SLOT(SL_U), acc, 32 * mi, 32 * ni, r31, hh); } }
        __syncthreads();
        { f32x16 acc; zero16(acc);
          if (wave < 4) { mm_tile(acc, SLOT(SL_U), 32 * mi, SLOT(SL_VT), 32 * ni, r31, hh); st_tileT(SLOT(SL_VNT), acc, 32 * mi, 32 * ni, r31, hh); }
          else { const int n = 32 * ni + r31;
              mm_tile(acc, SLOT(SL_KQT), 32 * mi, SLOT(SL_BBT), 32 * ni, r31, hh);
              const float gln = glv[n];
#pragma unroll
              for (int e = 0; e < 16; ++e) { const int m = 32 * mi + crow(e, hh); if (m == n) acc[e] += gln; }
              st_tileT_perm(CP + (size_t)item * 4096, acc, 32 * mi, 32 * ni, r31, hh);
              zero16(acc); mm_tile(acc, SLOT(SL_KQT), 32 * mi, SLOT(SL_A3), 32 * ni, r31, hh);
#pragma unroll
              for (int g = 0; g < 4; ++g) { const v2u rw = *(const LAS v2u*)(SLOT(SL_RH) + n * IP + 32 * mi + 8 * g + 4 * hh);
                  acc[4 * g] += bflo(rw.x); acc[4 * g + 1] += bfhi(rw.x); acc[4 * g + 2] += bflo(rw.y); acc[4 * g + 3] += bfhi(rw.y); }
              st_tileT_perm(CRQ + (size_t)item * 4096, acc, 32 * mi, 32 * ni, r31, hh); } }
        __syncthreads();
        { f32x16 acc; zero16(acc);
          if (wave < 4) { mm_tile(acc, SLOT(SL_A4), 32 * mi, SLOT(SL_VT), 32 * ni, r31, hh); mm_tile(acc, SLOT(SL_A3), 32 * mi, SLOT(SL_VNT), 32 * ni, r31, hh); st_dump(COI + (size_t)item * 4096, acc, mi, ni, lane); }
          else { mm_tile(acc, SLOT(SL_KBT), 32 * mi, SLOT(SL_VT), 32 * ni, r31, hh); mm_tile(acc, SLOT(SL_BBT), 32 * mi, SLOT(SL_VNT), 32 * ni, r31, hh); st_dump(CD + (size_t)item * 4096, acc, mi, ni, lane); } }
        __syncthreads(); S1T(tacc3);
    }
#undef SLOT
    if (PROBE_TA != 0 && blockIdx.x == 0 && tid == 0) { unsigned long long* st = (unsigned long long*)(a.ws + WS_CTL + 32768); st[20] = tacc0; st[21] = tacc1; st[22] = tacc2; st[23] = tacc3; }
}

constexpr int S2I_SLOT = 4096;
constexpr int S2I_GRP = 8 * S2I_SLOT * 2;
constexpr int S2I_MISC = 2 * S2I_GRP;
__device__ __forceinline__ int swz(int row, int col) { return row * 64 + ((((col) >> 3) ^ (((row) >> 1) & 7)) << 3) + ((col) & 7); }
__device__ __forceinline__ void mm_tileS(f32x16& acc, const LAS bf16* A, int am0, const LAS bf16* B, int bn0, int r31, int hh) {
    const int ra = am0 + r31, rb = bn0 + r31, sa = (ra >> 1) & 7, sb = (rb >> 1) & 7;
#pragma unroll
    for (int ks = 0; ks < 4; ++ks) { const int ch = 2 * ks + hh;
        const bf16x8_t af = *(const LAS bf16x8_t*)(A + ra * 64 + ((ch ^ sa) << 3)); const bf16x8_t bq = *(const LAS bf16x8_t*)(B + rb * 64 + ((ch ^ sb) << 3));
        acc = __builtin_amdgcn_mfma_f32_32x32x16_bf16(af, bq, acc, 0, 0, 0); }
}
__device__ __forceinline__ void st_tileTS(LAS bf16* img, const f32x16& acc, int m0, int n0, int r31, int hh) {
    const int row = n0 + r31, s = (row >> 1) & 7;
#pragma unroll
    for (int g = 0; g < 4; ++g) { v2u o; o.x = pk2(acc[4 * g], acc[4 * g + 1]); o.y = pk2(acc[4 * g + 2], acc[4 * g + 3]);
        *(LAS v2u*)(img + row * 64 + ((((m0 >> 3) + g) ^ s) << 3) + 4 * hh) = o; }
}
__device__ __forceinline__ void st_tileNS(LAS bf16* img, const f32x16& acc, int m0, int n0, int r31, int hh) {
#pragma unroll
    for (int e = 0; e < 16; ++e) img[swz(m0 + crow(e, hh), n0 + r31)] = (bf16)f2bf(acc[e]);
}
__device__ __forceinline__ v2u rd4S(const LAS bf16* img, int row, int col4) { return *(const LAS v2u*)(img + row * 64 + ((((col4) >> 3) ^ ((row >> 1) & 7)) << 3) + (col4 & 7)); }
__device__ __forceinline__ float bfel(const v4u& v, int i) { const unsigned w = v[i >> 1]; return (i & 1) ? bfhi(w) : bflo(w); }

__device__ __forceinline__ void phase_chunk_prep2(const Args& a, LAS unsigned char* lds, int G) {
    const int tid = threadIdx.x, lane0 = tid & 63, wave = __builtin_amdgcn_readfirstlane(tid >> 6);
    const int grp = wave >> 2, wq = wave & 3, mi = wq >> 1, ni = wq & 1;
    unsigned char* ws = a.ws;
    const bf16 *SR = (const bf16*)(ws + WS_SR), *SK = (const bf16*)(ws + WS_SK), *SV = (const bf16*)(ws + WS_SV);
    const bf16 *WFp = (const bf16*)((unsigned char*)a.out + DO_WF), *AFp = (const bf16*)((unsigned char*)a.out + DO_AF), *WBp = (const bf16*)((unsigned char*)a.out + DO_WB), *ABp = (const bf16*)((unsigned char*)a.out + DO_AB);
    bf16 *CP = (bf16*)(ws + WS_CP), *CD = (bf16*)(ws + WS_CD), *CRQ = (bf16*)(ws + WS_CRQ), *COI = (bf16*)(ws + WS_COI);
#define XS(g, i) ((LAS bf16*)(lds + (g) * S2I_GRP) + (i) * S2I_SLOT)
#define GS(i) XS(grp, i)
    LAS float* tot = (LAS float*)(lds + S2I_MISC);
    LAS float* glv = tot + 1024;
    v4u rawv[7]; float kac_n = 0.f, kkc_n = 0.f;
    unsigned long long q0_ = 0, q1_ = 0, q2_ = 0, q3_ = 0, ql_ = 0;
#define S2T(ACC) do { if (PROBE_TA != 0) { const unsigned long long n_ = __builtin_amdgcn_s_memrealtime(); ACC += n_ - ql_; ql_ = n_; } } while (0)
#define S1B_LOAD(P) do { const int ct_ = (P) & 63, h_ = ((P) >> 6) & 15, b_ = (P) >> 10; const unsigned o = bl_off(b_, h_, 8 * ct_ + wave, lane0); \
        rawv[0] = *(const v4u*)(SR + o); rawv[1] = *(const v4u*)(SK + o); rawv[2] = *(const v4u*)(SV + o); rawv[3] = *(const v4u*)(WFp + o); rawv[4] = *(const v4u*)(AFp + o); \
        rawv[5] = *(const v4u*)(WBp + o); rawv[6] = *(const v4u*)(ABp + o); kac_n = a.in[I_KA][h_ * 64 + lane0]; kkc_n = a.in[I_KK][h_ * 64 + lane0]; } while (0)
    S1B_LOAD(blockIdx.x);
    for (int pair = blockIdx.x; pair < 2048; pair += G) {
        const int ct = pair & 63, h = (pair >> 6) & 15, b = pair >> 10;
        int lane = lane0; asm volatile("" : "+v"(lane));
        const int r31 = lane & 31, hh = lane >> 5;
        int offA[4], offB[4], offT[4];
        { const int rA = 32 * mi + r31, rB = 32 * ni + r31, sA = (rA >> 1) & 7, sB = (rB >> 1) & 7;
#pragma unroll
          for (int q = 0; q < 4; ++q) { offA[q] = rA * 64 + (((2 * q + hh) ^ sA) << 3); offB[q] = rB * 64 + (((2 * q + hh) ^ sB) << 3); offT[q] = rB * 64 + (((4 * mi + q) ^ sB) << 3) + 4 * hh; } }
#define MMT(ACC, AIMG, BIMG) do { _Pragma("unroll") for (int ks_ = 0; ks_ < 4; ++ks_) ACC = __builtin_amdgcn_mfma_f32_32x32x16_bf16(*(const LAS bf16x8_t*)((AIMG) + offA[ks_]), *(const LAS bf16x8_t*)((BIMG) + offB[ks_]), ACC, 0, 0, 0); } while (0)
#define STT(IMG, ACC) do { _Pragma("unroll") for (int g_ = 0; g_ < 4; ++g_) { v2u o_; o_.x = pk2(ACC[4 * g_], ACC[4 * g_ + 1]); o_.y = pk2(ACC[4 * g_ + 2], ACC[4 * g_ + 3]); *(LAS v2u*)((IMG) + offT[g_]) = o_; } } while (0)
        if (PROBE_TA != 0) ql_ = __builtin_amdgcn_s_memrealtime();
        const int item = grp ? (((b * 16 + h) * 2 + 1) * 64 + (63 - ct)) : (((b * 16 + h) * 2) * 64 + ct);
        v4u khT[2], kbT[2], bbT[2], rhP[2], vT[2];
        { const int k = lane; const float kac = kac_n, kkc = kkc_n;
          float r[8], kr[8], kkv[8];
#pragma unroll
          for (int j = 0; j < 8; ++j) { r[j] = bfel(rawv[0], j); kr[j] = bfel(rawv[1], j); }
#pragma unroll
          for (int j = 0; j < 8; ++j) { const float k2 = kr[j] * kkc; const float ss = wave_sum(k2 * k2); kkv[j] = k2 * __builtin_amdgcn_rsqf(fmaxf(ss, 1e-24f)); }
          vT[0] = rawv[2];
          vT[1] = (v4u){__builtin_rotateleft32(rawv[2].w, 16), __builtin_rotateleft32(rawv[2].z, 16), __builtin_rotateleft32(rawv[2].y, 16), __builtin_rotateleft32(rawv[2].x, 16)};
#pragma unroll
          for (int d = 0; d < 2; ++d) { float pw = 1.0f;
#pragma unroll
              for (int j = 0; j < 8; ++j) pw *= 1.0f - bfel(rawv[3 + 2 * d], j);
              tot[(d * 8 + (d ? 7 - wave : wave)) * 64 + k] = -__builtin_amdgcn_logf(pw); }
          __syncthreads();
#pragma unroll
          for (int d = 0; d < 2; ++d) { const int sb = d ? 7 - wave : wave; float pre = 0.f, gl = 0.f;
#pragma unroll
              for (int q = 0; q < 8; ++q) { const float tq = tot[(d * 8 + q) * 64 + k]; gl += tq; if (q < sb) pre += tq; }
              const float xm0 = __builtin_amdgcn_exp2f(-pre), glx = __builtin_amdgcn_exp2f(-gl);
              if (sb == 0) glv[d * 64 + k] = glx;
              float khv[8], kbv[8], bbv[8], rhv[8]; float xm = xm0;
#pragma unroll
              for (int i = 0; i < 8; ++i) { const int j = d ? 7 - i : i; const int t = 8 * sb + i;
                  const float om = bfel(rawv[3 + 2 * d], j), a_ = bfel(rawv[4 + 2 * d], j);
                  const float kd_ = kr[j] * (1.0f + (a_ - 1.0f) * kac), fb_ = kkv[j] * a_;
                  const float xg = xm * (1.0f - om), xp = __builtin_amdgcn_rcpf(xg), xl = glx * xp;
                  const float kh = kkv[j] * xm, rh = r[j] * xg, kt = kd_ * xp, bt = fb_ * xp;
                  khv[i] = kh; rhv[i] = rh; kbv[i] = kd_ * xl; bbv[i] = -fb_ * xl; xm = xg;
                  const int o = swz(t, k);
                  XS(d, 0)[o] = (bf16)f2bf(kh); XS(d, 1)[o] = (bf16)f2bf(kt); XS(d, 2)[o] = (bf16)f2bf(bt); XS(d, 3)[o] = (bf16)f2bf(rh); }
              khT[d] = (v4u){pk2(khv[0], khv[1]), pk2(khv[2], khv[3]), pk2(khv[4], khv[5]), pk2(khv[6], khv[7])};
              kbT[d] = (v4u){pk2(kbv[0], kbv[1]), pk2(kbv[2], kbv[3]), pk2(kbv[4], kbv[5]), pk2(kbv[6], kbv[7])};
              bbT[d] = (v4u){pk2(bbv[0], bbv[1]), pk2(bbv[2], bbv[3]), pk2(bbv[4], bbv[5]), pk2(bbv[6], bbv[7])};
              rhP[d] = (v4u){pk2(rhv[0], rhv[1]), pk2(rhv[2], rhv[3]), pk2(rhv[4], rhv[5]), pk2(rhv[6], rhv[7])}; }
        }
        __syncthreads();
        if (pair + G < 2048) S1B_LOAD(pair + G);
#define JIT_T(SLOTI, REG) do { _Pragma("unroll") for (int d = 0; d < 2; ++d) { const int sb_ = d ? 7 - wave : wave; *(LAS v4u*)(XS(d, SLOTI) + lane * 64 + ((sb_ ^ ((lane >> 1) & 7)) << 3)) = REG[d]; } } while (0)
#pragma unroll
        for (int prod = 0; prod < 4; ++prod) { f32x16 acc; zero16(acc);
            MMT(acc, prod < 2 ? GS(0) : (prod == 2 ? GS(2) : GS(1)), prod == 0 ? GS(2) : (prod == 1 ? GS(1) : GS(3)));
            const int n = 32 * ni + r31;
#pragma unroll
            for (int e = 0; e < 16; ++e) { const int m = 32 * mi + crow(e, hh); const bool keep = prod < 2 ? (n < m) : (m <= n); acc[e] = keep ? (prod == 2 ? -acc[e] : acc[e]) : 0.f; }
            STT(GS(4 + prod), acc); }
        __syncthreads(); if (PROBE_TA != 0) ql_ = __builtin_amdgcn_s_memrealtime();
        float X[16];
        if (wq == 0) { const int bi = lane >> 4, c = lane & 15;
#pragma unroll
            for (int t = 0; t < 16; ++t) X[t] = (t == c) ? 1.f : 0.f;
#pragma unroll
            for (int s = 0; s < 15; ++s) { const int row = 16 * bi + s, sw_ = (row >> 1) & 7;
                const v4u q0 = *(const LAS v4u*)(GS(4) + row * 64 + (((2 * bi) ^ sw_) << 3)), q1 = *(const LAS v4u*)(GS(4) + row * 64 + (((2 * bi + 1) ^ sw_) << 3)); const float xs = X[s];
#pragma unroll
                for (int t = s + 1; t < 16; ++t) { const unsigned wv = t < 8 ? q0[t >> 1] : q1[(t - 8) >> 1]; const float nv = (t & 1) ? bfhi(wv) : bflo(wv); X[t] -= nv * xs; } } }
        else { for (int i = (wq - 1) * 64 + lane; i < 1024; i += 192) ((LAS v4u*)GS(0))[i] = (v4u){0u, 0u, 0u, 0u}; }
        __syncthreads();
        if (wq == 0) { const int bi = lane >> 4, c = lane & 15;
#pragma unroll
            for (int t = 0; t < 16; ++t) GS(0)[swz(16 * bi + t, 16 * bi + c)] = (bf16)f2bf(X[t]);
            const int row = 16 * bi + c, sw_ = (row >> 1) & 7;
            *(LAS v4u*)(GS(1) + row * 64 + (((2 * bi) ^ sw_) << 3)) = (v4u){pk2(X[0], X[1]), pk2(X[2], X[3]), pk2(X[4], X[5]), pk2(X[6], X[7])};
            *(LAS v4u*)(GS(1) + row * 64 + (((2 * bi + 1) ^ sw_) << 3)) = (v4u){pk2(X[8], X[9]), pk2(X[10], X[11]), pk2(X[12], X[13]), pk2(X[14], X[15])}; }
        __syncthreads(); S2T(q0_);
        f32x16 c2;
        { f32x16 acc; zero16(acc); MMT(acc, GS(4), GS(0));
          const int n = 32 * ni + r31;
#pragma unroll
          for (int e = 0; e < 16; ++e) { const int m = 32 * mi + crow(e, hh); if ((m >> 4) == (n >> 4)) acc[e] = 0.f; }
          STT(GS(2), acc); st_tileNS(GS(3), acc, 32 * mi, 32 * ni, r31, hh); }
        __syncthreads();
        zero16(c2); MMT(c2, GS(3), GS(2)); STT(GS(4), c2);
        __syncthreads();
        { f32x16 c3; zero16(c3); MMT(c3, GS(3), GS(4));
          const int n = 32 * ni + r31;
#pragma unroll
          for (int g = 0; g < 4; ++g) { const v2u mw = *(const LAS v2u*)(GS(2) + offT[g]);
#pragma unroll
              for (int i = 0; i < 4; ++i) { const int e = 4 * g + i; const int m = 32 * mi + crow(e, hh); const unsigned wv = mw[i >> 1]; const float mt = (i & 1) ? bfhi(wv) : bflo(wv);
                  c3[e] = ((m == n) ? 1.f : 0.f) - mt + c2[e] - c3[e]; } }
          STT(GS(0), c3); }
        __syncthreads();
        { f32x16 acc; zero16(acc); MMT(acc, GS(1), GS(0)); STT(GS(2), acc); }
        JIT_T(3, khT);
        __syncthreads(); S2T(q1_);
        { f32x16 acc; zero16(acc); MMT(acc, GS(2), GS(3)); STT(GS(1), acc);
          zero16(acc); MMT(acc, GS(5), GS(2)); STT(GS(0), acc); }
        JIT_T(4, vT);
        __syncthreads();
        JIT_T(2, bbT);
#pragma unroll
        for (int d = 0; d < 2; ++d) { const int sb_ = d ? 7 - wave : wave;
#pragma unroll
            for (int i = 0; i < 8; ++i) { const unsigned w_ = rhP[d][i >> 1]; XS(d, 3)[swz(8 * sb_ + i, lane)] = (bf16)((i & 1) ? (w_ >> 16) : (w_ & 0xffffu)); } }
        __syncthreads(); S2T(q2_);
        { f32x16 acc; zero16(acc); MMT(acc, GS(0), GS(4)); STT(GS(5), acc);
          const int n = 32 * ni + r31;
          zero16(acc); MMT(acc, GS(1), GS(2));
          const float gln = glv[grp * 64 + n];
#pragma unroll
          for (int e = 0; e < 16; ++e) { const int m = 32 * mi + crow(e, hh); if (m == n) acc[e] += gln; }
          st_tileT_perm(CP + (size_t)item * 4096, acc, 32 * mi, 32 * ni, r31, hh);
          zero16(acc); MMT(acc, GS(1), GS(6));
#pragma unroll
          for (int g = 0; g < 4; ++g) { const v2u rw = *(const LAS v2u*)(GS(3) + offT[g]);
              acc[4 * g] += bflo(rw.x); acc[4 * g + 1] += bfhi(rw.x); acc[4 * g + 2] += bflo(rw.y); acc[4 * g + 3] += bfhi(rw.y); }
          st_tileT_perm(CRQ + (size_t)item * 4096, acc, 32 * mi, 32 * ni, r31, hh); }
        __syncthreads();
        JIT_T(0, kbT);
        __syncthreads();
        { f32x16 acc; zero16(acc); MMT(acc, GS(7), GS(4)); MMT(acc, GS(6), GS(5)); st_dump(COI + (size_t)item * 4096, acc, mi, ni, lane);
          zero16(acc); MMT(acc, GS(0), GS(4)); MMT(acc, GS(2), GS(5)); st_dump(CD + (size_t)item * 4096, acc, mi, ni, lane); }
        __syncthreads(); S2T(q3_);
    }
    if (PROBE_TA != 0 && blockIdx.x == 0 && tid == 0) { unsigned long long* st = (unsigned long long*)(a.ws + WS_CTL + 32768); st[20] = q0_; st[21] = q1_; st[22] = q2_; st[23] = q3_; }
#undef MMT
#undef STT
#undef XS
#undef GS
#undef JIT_T
#undef S1B_LOAD
}

constexpr int S2_BUF = 2 * IMG_BYTES + 2 * 8192;
template <int DIR> __device__ __forceinline__ void s2_compute(LAS unsigned char* lds, bf16* OO, int b, int h, int wave, int lane) {
    const int r31 = lane & 31, hh = lane >> 5;
            const int j = wave;
            f32x16 X0, X1; zero16(X0); zero16(X1);
            __syncthreads();
            for (int c = 0; c < 64; ++c) {
                const LAS unsigned char* bb = lds + (c & 1) * S2_BUF;
                const LAS bf16* Pim = (const LAS bf16*)bb; const LAS bf16* Rim = (const LAS bf16*)(bb + IMG_BYTES);
                f32x16 aS0, aS1, aO0, aO1;
                { const LAS v4u* dp = (const LAS v4u*)(bb + 2 * IMG_BYTES);
                  const v4u d00 = dp[((0 * 2 + j) * 64 + lane) * 2], d01 = dp[((0 * 2 + j) * 64 + lane) * 2 + 1], d10 = dp[((1 * 2 + j) * 64 + lane) * 2], d11 = dp[((1 * 2 + j) * 64 + lane) * 2 + 1];
                  const LAS v4u* op = (const LAS v4u*)(bb + 2 * IMG_BYTES + 8192);
                  const v4u o00 = op[((0 * 2 + j) * 64 + lane) * 2], o01 = op[((0 * 2 + j) * 64 + lane) * 2 + 1], o10 = op[((1 * 2 + j) * 64 + lane) * 2], o11 = op[((1 * 2 + j) * 64 + lane) * 2 + 1];
#pragma unroll
                  for (int q = 0; q < 4; ++q) { aS0[2 * q] = bflo(d00[q]); aS0[2 * q + 1] = bfhi(d00[q]); aS0[8 + 2 * q] = bflo(d01[q]); aS0[8 + 2 * q + 1] = bfhi(d01[q]);
                      aS1[2 * q] = bflo(d10[q]); aS1[2 * q + 1] = bfhi(d10[q]); aS1[8 + 2 * q] = bflo(d11[q]); aS1[8 + 2 * q + 1] = bfhi(d11[q]);
                      aO0[2 * q] = bflo(o00[q]); aO0[2 * q + 1] = bfhi(o00[q]); aO0[8 + 2 * q] = bflo(o01[q]); aO0[8 + 2 * q + 1] = bfhi(o01[q]);
                      aO1[2 * q] = bflo(o10[q]); aO1[2 * q + 1] = bfhi(o10[q]); aO1[8 + 2 * q] = bflo(o11[q]); aO1[8 + 2 * q + 1] = bfhi(o11[q]); } }
#pragma unroll
                for (int ks = 0; ks < 4; ++ks) {
                    v4u bh;
#pragma unroll
                    for (int q = 0; q < 4; ++q) { const int e = 8 * (ks & 1) + 2 * q; const float x0 = (ks < 2) ? X0[e] : X1[e], x1 = (ks < 2) ? X0[e + 1] : X1[e + 1]; bh[q] = pk2(x0, x1); }
                    const bf16x8_t Bh = __builtin_bit_cast(bf16x8_t, bh);
                    const bf16x8_t p0 = *(const LAS bf16x8_t*)(Pim + (r31) * IP + 16 * ks + 8 * hh), p1 = *(const LAS bf16x8_t*)(Pim + (32 + r31) * IP + 16 * ks + 8 * hh);
                    const bf16x8_t q0 = *(const LAS bf16x8_t*)(Rim + (r31) * IP + 16 * ks + 8 * hh), q1 = *(const LAS bf16x8_t*)(Rim + (32 + r31) * IP + 16 * ks + 8 * hh);
                    aS0 = __builtin_amdgcn_mfma_f32_32x32x16_bf16(p0, Bh, aS0, 0, 0, 0); aS1 = __builtin_amdgcn_mfma_f32_32x32x16_bf16(p1, Bh, aS1, 0, 0, 0);
                    aO0 = __builtin_amdgcn_mfma_f32_32x32x16_bf16(q0, Bh, aO0, 0, 0, 0); aO1 = __builtin_amdgcn_mfma_f32_32x32x16_bf16(q1, Bh, aO1, 0, 0, 0); }
                const int tblk0 = (DIR ? (SEQ - CL * (c + 1)) : CL * c) >> 3;
#pragma unroll
                for (int i2 = 0; i2 < 2; ++i2)
#pragma unroll
                    for (int g = 0; g < 4; ++g) { const float x0 = i2 ? aO1[4 * g] : aO0[4 * g], x1 = i2 ? aO1[4 * g + 1] : aO0[4 * g + 1], x2 = i2 ? aO1[4 * g + 2] : aO0[4 * g + 2], x3 = i2 ? aO1[4 * g + 3] : aO0[4 * g + 3];
                        v2u w; int tblk, toff;
                        if (DIR) { w.x = pk2(x3, x2); w.y = pk2(x1, x0); tblk = tblk0 + 7 - 4 * i2 - g; toff = 4 - 4 * hh; } else { w.x = pk2(x0, x1); w.y = pk2(x2, x3); tblk = tblk0 + 4 * i2 + g; toff = 4 * hh; }
                        *(v2u*)(OO + bl_off(b, h, tblk, 32 * j + r31) + toff) = w; }
                X0 = aS0; X1 = aS1;
                __syncthreads();
            }
        }
__device__ __forceinline__ void phase_chunk_scan(const Args& a, LAS unsigned char* lds, int G) {
    const int tid = threadIdx.x, lane = tid & 63, wave = __builtin_amdgcn_readfirstlane(tid >> 6), r31 = lane & 31, hh = lane >> 5;
    unsigned char* ws = a.ws;
    const bf16 *CP = (const bf16*)(ws + WS_CP), *CD = (const bf16*)(ws + WS_CD), *CRQ = (const bf16*)(ws + WS_CRQ), *COI = (const bf16*)(ws + WS_COI);
    for (int sid = blockIdx.x; sid < 64; sid += G) {
        const int dir = sid & 1, h = (sid >> 1) & 15, b = sid >> 5;
        bf16* OO = (bf16*)((unsigned char*)a.out + (dir ? DO_WB : DO_WF));
        if (wave >= 2) {
            const int lt = tid - 128;
            v4u rg[6];
#define S2_LOAD(c) do { const size_t ib = ((size_t)sid * 64 + (c)) * 4096; _Pragma("unroll") for (int q = 0; q < 6; ++q) { const int idx = lt + 384 * q; if (idx < 2048) { const int arr = idx >> 9, ch = idx & 511; \
                const bf16* src = arr == 0 ? CP : (arr == 1 ? CRQ : (arr == 2 ? CD : COI)); rg[q] = *(const v4u*)(src + ib + ch * 8); } } } while (0)
#define S2_WRITE(c) do { LAS unsigned char* bb = lds + ((c) & 1) * S2_BUF; _Pragma("unroll") for (int q = 0; q < 6; ++q) { const int idx = lt + 384 * q; if (idx < 2048) { const int arr = idx >> 9, ch = idx & 511; \
                LAS unsigned char* dst = arr < 2 ? (bb + arr * IMG_BYTES + (ch >> 3) * (IP * 2) + (ch & 7) * 16) : (bb + 2 * IMG_BYTES + (arr - 2) * 8192 + ch * 16); *(LAS v4u*)dst = rg[q]; } } } while (0)
            S2_LOAD(0); S2_WRITE(0); S2_LOAD(1);
            __syncthreads();
            for (int c = 0; c < 64; ++c) {
                if (c + 1 < 64) S2_WRITE(c + 1);
                if (c + 2 < 64) S2_LOAD(c + 2);
                __syncthreads();
            }
#undef S2_LOAD
#undef S2_WRITE
        } else {
            if (dir) s2_compute<1>(lds, OO, b, h, wave, lane); else s2_compute<0>(lds, OO, b, h, wave, lane);
        }
        __syncthreads();
    }
}

__device__ __forceinline__ void phase_post(const Args& a, int G) {
    const int tid = threadIdx.x, lane = tid & 63, wave = tid >> 6;
    unsigned char* ws = a.ws;
    const bf16 *SR = (const bf16*)(ws + WS_SR), *SK = (const bf16*)(ws + WS_SK), *SV = (const bf16*)(ws + WS_SV), *GG = (const bf16*)(ws + WS_GG);
    const bf16 *AF = (const bf16*)((unsigned char*)a.out + DO_AF), *AB = (const bf16*)((unsigned char*)a.out + DO_AB);
    const bf16 *OF = (const bf16*)((unsigned char*)a.out + DO_WF), *OB = (const bf16*)((unsigned char*)a.out + DO_WB);
    bf16* YB = (bf16*)(ws + WS_YB);
    const int gw = blockIdx.x * NWAVES + wave, NGW = G * NWAVES;
    for (int item = gw; item < 2 * NHEAD * (SEQ / 8); item += NGW) { const int tblk = item & (SEQ / 8 - 1), h = (item >> 9) & 15, b = item >> 13; const int c = h * 64 + lane;
        const unsigned o = bl_off(b, h, tblk, lane);
        const v4u qf = *(const v4u*)(OF + o), qb = *(const v4u*)(OB + o), qv = *(const v4u*)(SV + o), qg = *(const v4u*)(GG + o), qr = *(const v4u*)(SR + o), qk = *(const v4u*)(SK + o), qaf = *(const v4u*)(AF + o), qab = *(const v4u*)(AB + o);
        const float gng = a.in[I_GNG][c], gnb = a.in[I_GNB][c], ka = a.in[I_KA][c], rk = a.in[I_RK][c];
        float ov[8], mean[8], var[8], bs[8];
#pragma unroll
        for (int i = 0; i < 8; ++i) { const unsigned wf_ = qf[i >> 1], wb_ = qb[i >> 1]; ov[i] = (i & 1) ? bfhi(wf_) + bfhi(wb_) : bflo(wf_) + bflo(wb_); }
#pragma unroll
        for (int i = 0; i < 8; ++i) mean[i] = wave_sum(ov[i]) * (1.0f / 64.0f);
#pragma unroll
        for (int i = 0; i < 8; ++i) { ov[i] -= mean[i]; var[i] = wave_sum(ov[i] * ov[i]) * (1.0f / 64.0f); }
#pragma unroll
        for (int i = 0; i < 8; ++i) { const unsigned wr_ = qr[i >> 1], wk_ = qk[i >> 1], wa_ = qaf[i >> 1], wc_ = qab[i >> 1];
            const float r = (i & 1) ? bfhi(wr_) : bflo(wr_), k = (i & 1) ? bfhi(wk_) : bflo(wk_), af = (i & 1) ? bfhi(wa_) : bflo(wa_), ab = (i & 1) ? bfhi(wc_) : bflo(wc_);
            bs[i] = wave_sum(r * k * (2.0f + (af + ab - 2.0f) * ka) * rk); }
        bf16* yrow = YB + (size_t)(b * SEQ + tblk * 8) * RWW + c;
#pragma unroll
        for (int i = 0; i < 8; ++i) { const unsigned wv_ = qv[i >> 1], wg_ = qg[i >> 1]; const float v = (i & 1) ? bfhi(wv_) : bflo(wv_), g = (i & 1) ? bfhi(wg_) : bflo(wg_);
            const float y = ov[i] * __builtin_amdgcn_rsqf(var[i] + GN_EPS) * gng + gnb;
            yrow[(size_t)i * RWW] = (bf16)f2bf((y + bs[i] * v) * g); } }
}

__global__ void __launch_bounds__(NTHR, 2) fwd_kernel(Args a) {
    extern __shared__ __attribute__((aligned(16))) unsigned char lds_raw[];
    LAS unsigned char* lds = (LAS unsigned char*)lds_raw;
    const int G = gridDim.x, lo = a.ph_lo, hi = a.ph_hi;
    unsigned char* ws = a.ws;
    volatile LAS unsigned* barst = (volatile LAS unsigned*)(lds + LDS_BARST);
    if (threadIdx.x < 2) barst[threadIdx.x] = 0u;
    __syncthreads();
    XcdBarrier bar = xcd_barrier_post((unsigned*)(ws + WS_CTL), barst);
    unsigned long long* stamps = (unsigned long long*)(ws + WS_CTL + 32768);
#define STAMP(i) do { if (PROBE_TA != 0 && blockIdx.x == PROBE_BLK && threadIdx.x == 0) stamps[i] = __builtin_amdgcn_s_memrealtime(); } while (0)
    STAMP(0);
#define IN(k) (lo <= (k) && (k) < hi)
#define SEAM(k) do { if (IN(k) && IN((k) + 1)) { if (USE_CG_SYNC) cg::this_grid().sync(); else xcd_barrier(bar); } STAMP((k) + 1); } while (0)
    typedef pg8::bf16_t B;
    if (IN(0)) REP(0) { phase_prologue(a, lds, G); } SEAM(0);
    if (IN(1)) REP(1) { pg8::Gemm g{(const B*)(ws + WS_XB), (const B*)(ws + WS_WIN), MTOK, INWP, DM}; pg8::StaticOrder S; S.init(MTOK, INWP, G, (int)blockIdx.x);
        pg8::EpiIn E{(B*)(ws + WS_U), (B*)(ws + WS_VG), (B*)(ws + WS_FEAT), (B*)(ws + WS_MG), (B*)(ws + WS_SGB), (const float*)(ws + WS_RSTD1), (float*)(ws + WS_PART)};
        pg8::gemm_phase<pg8::EpiIn, pg8::StaticOrder, true, true>(lds, g, S, E);
        if ((int)blockIdx.x >= 192) convert_small_weights(a, lds, G - 192, 192); } SEAM(1);
    if (IN(2)) REP(2) { phase_sgu(a, lds, G); } STAMP(3); __syncthreads();
    STAMP(4);
    if (IN(4)) REP(4) { phase_prep(a, lds, G); } SEAM(4);
    if (IN(5)) REP(5) { if (S1_V2) phase_chunk_prep2(a, lds, G); else phase_chunk_prep(a, lds, G); xcd_barrier(bar); STAMP(15);
        if ((int)blockIdx.x < 64) phase_chunk_scan(a, lds, G);
        else if ((int)blockIdx.x < 192) { pg8::Gemm g{(const B*)(ws + WS_YA), (const B*)(ws + WS_WPA), MTOK, DM, SGW}; pg8::StaticOrder S; S.init(MTOK, DM, 128, (int)blockIdx.x - 64);
            pg8::EpiProj<0> E{(B*)(ws + WS_MG), nullptr};
            pg8::gemm_phase<pg8::EpiProj<0>, pg8::StaticOrder, true, true>(lds, g, S, E); } } SEAM(5);
    if (IN(6)) REP(6) { phase_post(a, G); phase_ffn_weights(a, lds, G); } SEAM(6);
    if (IN(7)) { pg8::Gemm g{(const B*)(ws + WS_YB), (const B*)(ws + WS_WPB), MTOK, DM, RWW}; pg8::StaticOrder S; S.init(MTOK, DM, G, (int)blockIdx.x);
        pg8::EpiProj<1> E{(B*)(ws + WS_MG), (const B*)(ws + WS_SGB)};
        pg8::gemm_phase<pg8::EpiProj<1>, pg8::StaticOrder, true, true>(lds, g, S, E, PROBE_TA != 0 ? stamps + 32 : nullptr); } SEAM(7);
    if (IN(8)) { pg8::Gemm g{(const B*)(ws + WS_MG), (const B*)(ws + WS_WOUT), MTOK, DM, DM}; pg8::StaticOrder S; S.init(MTOK, DM, G, (int)blockIdx.x);
        pg8::EpiOutNorm E{a.in[I_X], (B*)(ws + WS_X1B), (float*)(ws + WS_RSTD2), (float*)(ws + WS_XCH + 262144), (unsigned*)(ws + WS_CTL + CTL_CNT + 8192)};
        pg8::gemm_phase<pg8::EpiOutNorm, pg8::StaticOrder, false, true>(lds, g, S, E); } SEAM(8);
    STAMP(10);
    if (IN(10)) REP(10) { pg8::Gemm g{(const B*)(ws + WS_X1B), (const B*)(ws + WS_WG), MTOK, DFF, DM}; pg8::StaticOrder S; S.init(MTOK, DFF, G, (int)blockIdx.x);
        pg8::EpiGate E{(B*)(ws + WS_GT), (const float*)(ws + WS_RSTD2)};
        pg8::gemm_phase<pg8::EpiGate, pg8::StaticOrder, true, true>(lds, g, S, E);
        if ((int)blockIdx.x >= 192) convert_wup_tail(a, lds, G - 192, 192); } SEAM(10);
    if (IN(11)) REP(11) { pg8::Gemm g{(const B*)(ws + WS_X1B), (const B*)(ws + WS_WU), MTOK, DFF, DM}; pg8::StaticOrder S; S.init(MTOK, DFF, G, (int)blockIdx.x);
        pg8::EpiUp E{(const B*)(ws + WS_GT), (B*)(ws + WS_A3), (const float*)(ws + WS_RSTD2), a.in[I_CW], a.in[I_CB]};
        pg8::gemm_phase<pg8::EpiUp, pg8::StaticOrder, true, true>(lds, g, S, E);
        if ((int)blockIdx.x >= 192) convert_wdown_half(a, lds, -1, G - 192, 192); } SEAM(11);
    if (IN(12)) { pg8::Gemm g{(const B*)(ws + WS_A3), (const B*)(ws + WS_WD), MTOK, DM, DFF}; pg8::StaticOrder S; S.init(MTOK, DM, G, (int)blockIdx.x);
        if (G == 256) { pg8::EpiDownNorm E{(const B*)(ws + WS_X1B), a.out, a.in[I_NFG], (float*)(ws + WS_XCH), (unsigned*)(ws + WS_CTL + CTL_CNT)};
            pg8::gemm_phase<pg8::EpiDownNorm, pg8::StaticOrder, false, true>(lds, g, S, E); } }
    STAMP(13);
    if (PROBE_TA != 0 && blockIdx.x == PROBE_BLK) { STAMP(14); __threadfence(); __syncthreads();
        float ta = 0.f, tb = 0.f;
        for (int k = 0; k < 14; ++k) { const float d = (float)(stamps[k + 1] - stamps[k]) * 0.01f; if ((PROBE_TA >> k) & 1) ta += d; if ((PROBE_TB >> k) & 1) tb += d; }
        if (PROBE_TB == -1) tb = (float)(stamps[15] - stamps[5]) * 0.01f;
        if (PROBE_TB == -2) tb = (float)(stamps[13] - stamps[0]) * 0.01f - 1000.f;
        if (PROBE_TB <= -40) { const int q = -PROBE_TB - 40; tb = (float)(stamps[32 + q + 1] - stamps[32 + q]) * 0.01f; ta = (float)(stamps[32 + q + 2] - stamps[32 + q + 1]) * 0.01f; }
        else if (PROBE_TB <= -20) { tb = (float)stamps[-PROBE_TB] * 0.01f; ta = (float)stamps[-PROBE_TB + 1] * 0.01f; }
        if (threadIdx.x == 0) { a.out[0] = ta * (1.0f / PROBE_SA); if (PROBE_TB != 0) a.out[1] = tb * (1.0f / PROBE_SB); } }
#undef IN
#undef SEAM
}

extern "C" void kernel_launch(void* const* d_in, const int* in_sizes, int n_in, void* d_out, int out_size, void* d_ws, size_t ws_size, hipStream_t stream) {
    static int grid = 0;
    if (grid == 0) {
        if (n_in != 33 || out_size != MTOK * DM || ws_size < WS_END) { fprintf(stderr, "kernel_launch: unexpected shapes (n_in %d, out %d, ws %zu); nothing launched\n", n_in, out_size, ws_size); grid = -1; return; }
        int dev = 0, cus = 0, per_cu = 0;
        if (hipGetDevice(&dev) != hipSuccess || hipDeviceGetAttribute(&cus, hipDeviceAttributeMultiprocessorCount, dev) != hipSuccess) { grid = -1; return; }
        if (hipFuncSetAttribute((const void*)fwd_kernel, hipFuncAttributeMaxDynamicSharedMemorySize, LDS_BYTES) != hipSuccess) { fprintf(stderr, "kernel_launch: hipFuncSetAttribute failed\n"); grid = -1; return; }
        if (hipOccupancyMaxActiveBlocksPerMultiprocessor(&per_cu, (const void*)fwd_kernel, NTHR, LDS_BYTES) != hipSuccess || per_cu < 1) { fprintf(stderr, "kernel_launch: occupancy query says %d blocks per CU\n", per_cu); (void)hipGetLastError(); per_cu = 1; }
        grid = cus;
        if (grid != 256) { fprintf(stderr, "kernel_launch: built for a 256-CU device (grid %d)\n", grid); grid = -1; return; }
        if (grid < 128) { fprintf(stderr, "kernel_launch: needs >= 128 CUs (phase 5 splits the grid)\n"); grid = -1; return; }
    }
    if (grid < 0) return;
    if (hipMemsetAsync((char*)d_ws + WS_CTL, 0, CTL_ZERO_BYTES, stream) != hipSuccess) { fprintf(stderr, "kernel_launch: memset failed\n"); return; }
    Args a{};
    for (int i = 0; i < 33; ++i) a.in[i] = (const float*)d_in[i];
    a.out = (float*)d_out; a.ws = (unsigned char*)d_ws;
#if MK_SPLIT
    for (int p = 0; p < NPHASE; ++p) { a.ph_lo = p; a.ph_hi = p + 1; void* args[] = {&a};
        hipError_t e = hipLaunchCooperativeKernel((const void*)fwd_kernel, dim3(grid), dim3(NTHR), args, LDS_BYTES, stream);
        if (e != hipSuccess) { fprintf(stderr, "kernel_launch: launch of phase %d failed: %s\n", p, hipGetErrorString(e)); break; } }
#else
    a.ph_lo = 0; a.ph_hi = NPHASE; void* args[] = {&a};
    hipError_t e = hipLaunchCooperativeKernel((const void*)fwd_kernel, dim3(grid), dim3(NTHR), args, LDS_BYTES, stream);
    if (e != hipSuccess) fprintf(stderr, "kernel_launch: cooperative launch failed: %s (grid %d)\n", hipGetErrorString(e), grid);
#endif
}
```

```cpp
#include <hip/hip_runtime.h>
#include <hip/hip_cooperative_groups.h>
#include <cstdio>
#include <cstdint>
namespace cg = cooperative_groups;
namespace pg8 {
#define PG8_LAS __attribute__((address_space(3)))
typedef unsigned short bf16_t;
typedef short bf16x8 __attribute__((ext_vector_type(8)));
typedef float f32x4 __attribute__((ext_vector_type(4)));
typedef unsigned u32x4 __attribute__((ext_vector_type(4)));
constexpr int BM = 256, BK = 64, HALF = 128, HTB = HALF * BK * 2  , STAGE_BYTES = 8 * HTB, NXCD = 8, WGM = 4;

__host__ __device__ __forceinline__ int lds_byte(int r, int c) { const int st = (r >> 4) * 2 + (c >> 5), rr = r & 15, cc = c & 31, ob = rr * 64 + cc * 2; return st * 1024 + (ob ^ (((ob >> 9) & 1) << 5)); }
__host__ __device__ __forceinline__ void stage_rc(int b, int& R, int& C) { const int st = b / 1024, sb = b % 1024, swz = sb ^ (((sb >> 9) & 1) << 5); R = (st >> 1) * 16 + swz / 64; C = (st & 1) * 32 + (swz % 64) / 2; }
__host__ __device__ __forceinline__ int perm32(int rho) { const int n = rho >> 4, i = rho & 15; return 8 * (i >> 2) + 4 * n + (i & 3); }

struct Unit { int pm, pn; };
struct Gemm { const bf16_t* A; const bf16_t* Bt; int M, N, K; };

struct StaticOrder {
    int nM, nN, nwg, G, c;
    __host__ __device__ void init(int M, int N, int G_, int c_) { nM = M / BM; nN = N / BM; nwg = nM * nN; G = G_; c = c_; }
    __host__ __device__ bool next(int i, Unit& u) const {
        const long L = (long)i * G + c; if (L >= nwg) return false;
        int wgid = (int)L; { const int q = nwg / NXCD, r = nwg % NXCD, xcd = wgid % NXCD, off = wgid / NXCD; wgid = (xcd < r ? xcd * (q + 1) : r * (q + 1) + (xcd - r) * q) + off; }
        const int nig = WGM * nN, gid = wgid / nig, fm = gid * WGM, gsz = (nM - fm) < WGM ? (nM - fm) : WGM;
        u.pm = fm + ((wgid % nig) % gsz); u.pn = (wgid % nig) / gsz; return true;
    }
    __device__ __forceinline__ void a_ready(const Unit&) const {}
    __device__ __forceinline__ void done(const Unit&) const {}
};

__device__ __forceinline__ unsigned cvt_pk_bf16(float lo, float hi) { unsigned r; asm volatile("v_cvt_pk_bf16_f32 %0, %1, %2" : "=v"(r) : "v"(lo), "v"(hi)); return r; }
typedef float f32x2 __attribute__((ext_vector_type(2)));
__device__ __forceinline__ f32x2 gelu_pk(f32x2 v) {
    const f32x2 av = __builtin_elementwise_abs(v), d = av * 0.2316418882f + 1.0f;
    f32x2 t; t.x = __builtin_amdgcn_rcpf(d.x); t.y = __builtin_amdgcn_rcpf(d.y);
    f32x2 q = t * 0.5307027145f + (-0.7265760135f); q = q * t + 0.7107068705f; q = q * t + (-0.142248368f); q = q * t + 0.127414796f; q = q * t;
    const f32x2 s = (v * v) * (-0.72134752044f);
    f32x2 e; e.x = __builtin_amdgcn_exp2f(s.x); e.y = __builtin_amdgcn_exp2f(s.y);
    const f32x2 m = v * (q * e), r = v - m;
    f32x2 o; o.x = v.x < 0.f ? m.x : r.x; o.y = v.y < 0.f ? m.y : r.y; return o;
}

template <class Epi, class Sched, bool ALIGN_EPI = false, bool SP2 = false>
__device__ __forceinline__ void gemm_phase(PG8_LAS unsigned char* lds, const Gemm g, const Sched& S, const Epi& E, unsigned long long* tm = nullptr) {
#define PG8_TM(i) do { if (tm && blockIdx.x == 0 && threadIdx.x == 0) tm[i] = __builtin_amdgcn_s_memrealtime(); } while (0)
    PG8_TM(0);
    const int tid = threadIdx.x, wid = __builtin_amdgcn_readfirstlane(tid >> 6), lane = tid & 63, wr = wid >> 2, wc = wid & 3, fr = lane & 15, fq = lane >> 4;
    const int K = g.K, nt = K / BK;
    unsigned voffA[2], voffB[2];
#pragma unroll
    for (int i = 0; i < 2; ++i) { int R, C; stage_rc(tid * 16 + i * 8192, R, C); const int Rb = Epi::PERM ? ((R & ~31) + perm32(R & 31)) : R;
        voffA[i] = (unsigned)(R * K + C) * 2u; voffB[i] = (unsigned)(Rb * K + C) * 2u; }
    const size_t kstep = (size_t)(BK * 2);
    const size_t hstep = (size_t)HALF * K * 2;
    const size_t tstep = 2 * hstep;
    const unsigned ldsw = (unsigned)wid * 1024u;
    const int aoff = lds_byte(wr * 64 + fr, fq * 8), boff = lds_byte(wc * 32 + fr, fq * 8);
#define PG8_SA(b, h) (((b) * 2 + (h)) * HTB)
#define PG8_SB(b, h) ((4 + (b) * 2 + (h)) * HTB)
#define PG8_STAGE(bufoff, gbase, voff) do { _Pragma("unroll") for (int _i = 0; _i < 2; ++_i) \
        __builtin_amdgcn_global_load_lds((const unsigned*)((const char*)(gbase) + (voff)[_i]), (PG8_LAS unsigned*)(lds + (bufoff) + ldsw + _i * 8192), 16, 0, 0); } while (0)
#define PG8_LDA(dst, b, h) do { _Pragma("unroll") for (int m = 0; m < 4; ++m) _Pragma("unroll") for (int k = 0; k < 2; ++k) dst[m][k] = *(const PG8_LAS bf16x8*)(lds + PG8_SA(b, h) + aoff + m * 2048 + k * 1024); } while (0)
#define PG8_LDB(dst, b, h) do { _Pragma("unroll") for (int n = 0; n < 2; ++n) _Pragma("unroll") for (int k = 0; k < 2; ++k) dst[n][k] = *(const PG8_LAS bf16x8*)(lds + PG8_SB(b, h) + boff + n * 2048 + k * 1024); } while (0)
#define PG8_MMA(ai, bj, At, Bt) do { __builtin_amdgcn_s_setprio(3); _Pragma("unroll") for (int m = 0; m < 4; ++m) _Pragma("unroll") for (int n = 0; n < 2; ++n) _Pragma("unroll") for (int k = 0; k < 2; ++k) \
        acc[ai][bj][m][n] = __builtin_amdgcn_mfma_f32_16x16x32_bf16(Bt[n][k], At[m][k], acc[ai][bj][m][n], 0, 0, 0); __builtin_amdgcn_s_setprio(0); } while (0)
#define PG8_WAIT_V(n) asm volatile("s_waitcnt vmcnt(" #n ")" ::: "memory")
#define PG8_WAIT_L(n) asm volatile("s_waitcnt lgkmcnt(" #n ")" ::: "memory")
#define PG8_BAR __builtin_amdgcn_s_barrier()
#define PG8_SCHED __builtin_amdgcn_sched_barrier(0)
    Unit cur, nxt; int ui = 0;
    if (!S.next(0, cur)) return;
    f32x4 acc[2][2][4][2];
#pragma unroll
    for (int a = 0; a < 2; ++a)
#pragma unroll
        for (int b = 0; b < 2; ++b)
#pragma unroll
            for (int m = 0; m < 4; ++m)
#pragma unroll
                for (int n = 0; n < 2; ++n) acc[a][b][m][n] = (f32x4){0.f, 0.f, 0.f, 0.f};
    bf16x8 At[4][2], B0[2][2], B1[2][2];
    const char* cA = (const char*)g.A + (size_t)cur.pm * tstep; const char* cB = (const char*)g.Bt + (size_t)cur.pn * tstep;
    S.a_ready(cur);
    if constexpr (SP2) {
        PG8_STAGE(PG8_SB(0, 0), cB, voffB); PG8_STAGE(PG8_SB(0, 1), cB + hstep, voffB); PG8_STAGE(PG8_SA(0, 0), cA, voffA); PG8_STAGE(PG8_SA(0, 1), cA + hstep, voffA);
        if (wr == 1) PG8_BAR;
        PG8_WAIT_V(2); PG8_BAR;
        PG8_STAGE(PG8_SB(1, 0), cB + kstep, voffB); PG8_STAGE(PG8_SA(1, 0), cA + kstep, voffA); PG8_STAGE(PG8_SB(1, 1), cB + hstep + kstep, voffB);
        PG8_WAIT_V(6); PG8_BAR;
    } else {
        PG8_STAGE(PG8_SB(0, 0), cB, voffB); PG8_STAGE(PG8_SA(0, 0), cA, voffA); PG8_STAGE(PG8_SB(0, 1), cB + hstep, voffB); PG8_STAGE(PG8_SA(0, 1), cA + hstep, voffA);
        if (wr == 1) PG8_BAR;
        PG8_WAIT_V(4); PG8_BAR;
        PG8_STAGE(PG8_SB(1, 0), cB + kstep, voffB); PG8_STAGE(PG8_SA(1, 0), cA + kstep, voffA); PG8_STAGE(PG8_SB(1, 1), cB + hstep + kstep, voffB);
        PG8_WAIT_V(6); PG8_BAR;
    }
    PG8_TM(1);
    for (;;) {
        const bool has_next = S.next(ui + 1, nxt);
        const char* nA = has_next ? (const char*)g.A + (size_t)nxt.pm * tstep : cA; const char* nB = has_next ? (const char*)g.Bt + (size_t)nxt.pn * tstep : cB;
        for (int t = 0; t < nt; t += 2) {
            const bool last = (t == nt - 2);
            const char* a1 = cA + (size_t)(t + 1) * kstep;
            const char* a2 = last ? nA : cA + (size_t)(t + 2) * kstep; const char* b2 = last ? nB : cB + (size_t)(t + 2) * kstep;
            const char* a3 = a2 + kstep; const char* b3 = b2 + kstep;
            if (last && has_next) S.a_ready(nxt);
            if constexpr (SP2) {
            PG8_LDB(B0, 0, 0); PG8_LDB(B1, 0, 1); PG8_SCHED; PG8_LDA(At, 0, 0); PG8_STAGE(PG8_SA(1, 1), a1 + hstep, voffA);
            PG8_WAIT_V(8); PG8_WAIT_L(0); PG8_BAR; PG8_MMA(0, 0, At, B0); PG8_MMA(0, 1, At, B1); PG8_BAR; PG8_SCHED;
            PG8_LDA(At, 0, 1); PG8_STAGE(PG8_SB(0, 0), b2, voffB); PG8_STAGE(PG8_SB(0, 1), b2 + hstep, voffB); PG8_STAGE(PG8_SA(0, 0), a2, voffA);
            PG8_WAIT_V(8); PG8_WAIT_L(0); PG8_BAR; PG8_MMA(1, 0, At, B0); PG8_MMA(1, 1, At, B1); PG8_BAR; PG8_SCHED;
            PG8_LDB(B0, 1, 0); PG8_LDB(B1, 1, 1); PG8_SCHED; PG8_LDA(At, 1, 0); PG8_STAGE(PG8_SA(0, 1), a2 + hstep, voffA);
            PG8_WAIT_V(8); PG8_WAIT_L(0); PG8_BAR; PG8_MMA(0, 0, At, B0); PG8_MMA(0, 1, At, B1); PG8_BAR; PG8_SCHED;
            PG8_LDA(At, 1, 1); PG8_STAGE(PG8_SB(1, 0), b3, voffB); PG8_STAGE(PG8_SB(1, 1), b3 + hstep, voffB); PG8_STAGE(PG8_SA(1, 0), a3, voffA);
            PG8_WAIT_V(8); PG8_WAIT_L(0); PG8_BAR; PG8_MMA(1, 0, At, B0); PG8_MMA(1, 1, At, B1); PG8_BAR; PG8_SCHED;
            } else {
            PG8_LDB(B0, 0, 0); PG8_SCHED; PG8_LDA(At, 0, 0); PG8_STAGE(PG8_SA(1, 1), a1 + hstep, voffA);
            PG8_WAIT_L(8); PG8_BAR; PG8_WAIT_L(0); PG8_MMA(0, 0, At, B0); PG8_BAR; PG8_SCHED;
            PG8_LDB(B1, 0, 1); PG8_STAGE(PG8_SB(0, 0), b2, voffB);
            PG8_BAR; PG8_WAIT_L(0); PG8_MMA(0, 1, At, B1); PG8_BAR;
            PG8_LDA(At, 0, 1); PG8_STAGE(PG8_SA(0, 0), a2, voffA);
            PG8_BAR; PG8_WAIT_L(0); PG8_MMA(1, 0, At, B0); PG8_BAR; PG8_SCHED;
            PG8_STAGE(PG8_SB(0, 1), b2 + hstep, voffB);
            PG8_WAIT_V(6); PG8_BAR; PG8_MMA(1, 1, At, B1); PG8_BAR;
            PG8_LDB(B0, 1, 0); PG8_SCHED; PG8_LDA(At, 1, 0); PG8_STAGE(PG8_SA(0, 1), a2 + hstep, voffA);
            PG8_WAIT_L(8); PG8_BAR; PG8_WAIT_L(0); PG8_MMA(0, 0, At, B0); PG8_BAR; PG8_SCHED;
            PG8_LDB(B1, 1, 1); PG8_STAGE(PG8_SB(1, 0), b3, voffB);
            PG8_BAR; PG8_WAIT_L(0); PG8_MMA(0, 1, At, B1); PG8_BAR;
            PG8_LDA(At, 1, 1); PG8_STAGE(PG8_SA(1, 0), a3, voffA);
            PG8_BAR; PG8_WAIT_L(0); PG8_MMA(1, 0, At, B0); PG8_BAR; PG8_SCHED;
            PG8_STAGE(PG8_SB(1, 1), b3 + hstep, voffB);
            PG8_WAIT_V(6); PG8_BAR; PG8_MMA(1, 1, At, B1); PG8_BAR;
            }
        }
        PG8_TM(2);
        if constexpr (ALIGN_EPI) { if (wr == 0) PG8_BAR; }
        if constexpr (!Epi::AFTER_DRAIN) { E(acc, cur, wr, wc, fr, fq); S.done(cur); }
        PG8_TM(3);
        if (!has_next) break;
#pragma unroll
        for (int a = 0; a < 2; ++a)
#pragma unroll
            for (int b = 0; b < 2; ++b)
#pragma unroll
                for (int m = 0; m < 4; ++m)
#pragma unroll
                    for (int n = 0; n < 2; ++n) acc[a][b][m][n] = (f32x4){0.f, 0.f, 0.f, 0.f};
        cur = nxt; cA = nA; cB = nB; ++ui;
        if constexpr (ALIGN_EPI) { if (wr == 1) PG8_BAR; }
    }
    PG8_WAIT_V(0);
    if constexpr (!ALIGN_EPI) { if (wr == 0) PG8_BAR; }
    PG8_BAR;
    if constexpr (Epi::AFTER_DRAIN) { E.fused(acc, cur, wr, wc, fr, fq, lds, wid, lane); S.done(cur); }
    PG8_TM(4);
#undef PG8_TM
#undef PG8_SA
#undef PG8_SB
#undef PG8_STAGE
#undef PG8_LDA
#undef PG8_LDB
#undef PG8_MMA
#undef PG8_WAIT_V
#undef PG8_WAIT_L
#undef PG8_BAR
#undef PG8_SCHED
}
}

constexpr int NWAVES = 8, NTHR = 512;
constexpr int DM = 2048, SEQ = 4096, MTOK = 8192;
constexpr int SGW = 1024, RWW = 1024, NHEAD = 16, HDIM = 64;
constexpr int FEAT = 3488, FEATP = 3584, INW = 9632, INWP = 9728;
constexpr int DFF = 5632;
constexpr float NORM_EPS = 1e-6f, LN_EPS = 1e-5f, GN_EPS = 64e-5f;
#ifndef MK_SPLIT
#define MK_SPLIT 0
#endif
constexpr int NPHASE = 14;
#ifndef S1_V2
#define S1_V2 1
#endif
#ifndef USE_CG_SYNC
#define USE_CG_SYNC 0
#endif
#ifndef PROBE_TA
#define PROBE_TA 0
#endif
#ifndef PROBE_TB
#define PROBE_TB 0
#endif
#ifndef PROBE_SA
#define PROBE_SA 100.0f
#endif
#ifndef PROBE_SB
#define PROBE_SB 10.0f
#endif
#ifndef PROBE_BLK
#define PROBE_BLK 0
#endif
#ifndef PROBE_REP
#define PROBE_REP -1
#endif
#define REP(k) _Pragma("nounroll") for (int rep_ = 0; rep_ < (((k) == PROBE_REP) ? 2 - a.ph_lo : 1); ++rep_)

constexpr size_t MiB = 1u << 20;
constexpr size_t WS_CTL = 0, CTL_ZERO_BYTES = 65536;
constexpr size_t WS_RSTD1 = 1 * MiB, WS_RSTD2 = 1 * MiB + 65536, WS_W2T = 1 * MiB + 131072;
constexpr size_t WS_WPA = 2 * MiB, WS_WPB = 6 * MiB, WS_WOUT = 10 * MiB, WS_WG = 18 * MiB, WS_WU = 40 * MiB, WS_WD = 62 * MiB;
constexpr size_t WS_WIN = 84 * MiB, WS_XB = 122 * MiB;
constexpr size_t WS_MG = 154 * MiB, WS_SGB = 186 * MiB;
constexpr size_t WS_FEAT = 218 * MiB;
constexpr size_t WS_GG = 282 * MiB;
constexpr size_t WS_SR = 84 * MiB, WS_SK = 100 * MiB, WS_SV = 116 * MiB, WS_SKK = 132 * MiB;
constexpr size_t WS_BS = 149 * MiB;
constexpr size_t WS_XCH = 148 * MiB;
constexpr size_t WS_PART = 82 * MiB;
constexpr size_t CTL_CNT = 40960;
constexpr size_t WS_YA = 132 * MiB;
constexpr size_t WS_OF = 218 * MiB, WS_OB = 234 * MiB, WS_YB = 250 * MiB;
constexpr size_t WS_X1B = 84 * MiB, WS_GT = 116 * MiB, WS_A3 = 204 * MiB;
constexpr size_t WS_END = 298 * MiB;
constexpr size_t WS_CP = 18 * MiB, WS_CD = 50 * MiB, WS_CRQ = 218 * MiB, WS_COI = 250 * MiB;
constexpr size_t WS_U = 18 * MiB, WS_VG = 34 * MiB;
constexpr size_t DO_WF = 0, DO_AF = 16 * MiB, DO_WB = 32 * MiB, DO_AB = 48 * MiB;

constexpr int LDS_BYTES = 147456;
constexpr int LDS_BARST = 147456 - 64;

#define LAS __attribute__((address_space(3)))
typedef unsigned short bf16;
typedef unsigned v4u __attribute__((ext_vector_type(4)));
typedef unsigned v2u __attribute__((ext_vector_type(2)));
typedef float f32x4 __attribute__((ext_vector_type(4)));
#define LDS_WAIT() asm volatile("s_waitcnt lgkmcnt(0)" ::: "memory")
typedef __bf16 hwbf2 __attribute__((ext_vector_type(2)));
typedef float hwf2 __attribute__((ext_vector_type(2)));
__device__ __forceinline__ unsigned f2bf(float f) { return (unsigned)__builtin_bit_cast(unsigned short, (__bf16)f); }
__device__ __forceinline__ unsigned pk2(float lo, float hi) { const hwf2 v = {lo, hi}; return __builtin_bit_cast(unsigned, __builtin_convertvector(v, hwbf2)); }
__device__ __forceinline__ float bf2f(unsigned b) { return __uint_as_float(b << 16); }
__device__ __forceinline__ float bflo(unsigned w) { return __uint_as_float(w << 16); }
__device__ __forceinline__ float bfhi(unsigned w) { return __uint_as_float(w & 0xffff0000u); }
__device__ __forceinline__ float sigmoidf_(float x) { return __builtin_amdgcn_rcpf(1.0f + __builtin_amdgcn_exp2f(-1.44269504089f * x)); }
template <int CTRL> __device__ __forceinline__ float dpp_f(float x) { return __int_as_float(__builtin_amdgcn_update_dpp(0, __float_as_int(x), CTRL, 0xF, 0xF, true)); }
__device__ __forceinline__ float allreduce16(float x) { x += dpp_f<0xB1>(x); x += dpp_f<0x4E>(x); x += dpp_f<0x141>(x); x += dpp_f<0x140>(x); return x; }
__device__ __forceinline__ unsigned bl_off(int b, int h, int tblk, int k) { return ((((unsigned)(b * 16 + h) * (SEQ / 8) + (unsigned)tblk) * 64u + (unsigned)k) * 8u); }
__device__ __forceinline__ int crow(int e, int hh) { return (e & 3) + 8 * (e >> 2) + 4 * hh; }
__device__ __forceinline__ float wave_sum(float v) { v = allreduce16(v); v += __shfl_xor(v, 16); v += __shfl_xor(v, 32); return v; }

namespace pg8 {
struct EpiIn {
    static constexpr bool PERM = true, AFTER_DRAIN = false;
    bf16_t *U, *VG, *FT, *SGA, *SGB; const float* rstd; float* part;
    __device__ __forceinline__ void operator()(const f32x4 (&acc)[2][2][4][2], const Unit& u, int wr, int wc, int fr, int fq) const {
        const int row0 = u.pm * BM + wr * 64 + fr; const int pn = u.pn;
        bf16_t* base; int ldc, colt, mode;
        if (pn < 4) { base = U; ldc = 1024; colt = pn * 256; mode = 0; }
        else if (pn < 8) { base = VG; ldc = 1024; colt = (pn - 4) * 256; mode = 0; }
        else if (pn < 22) { base = FT; ldc = FEATP; colt = (pn - 8) * 256; mode = 1; }
        else if (pn < 30) { base = SGA; ldc = 2048; colt = (pn - 22) * 256; mode = 2; }
        else { base = SGB; ldc = 2048; colt = (pn - 30) * 256; mode = 2; }
        const int col0 = colt + wc * 32 + 8 * fq;
#pragma unroll
        for (int ai = 0; ai < 2; ++ai)
#pragma unroll
            for (int m = 0; m < 4; ++m) { const int row = row0 + ai * HALF + m * 16; const float rs = rstd[row]; bf16_t* rowp = base + (size_t)row * ldc + col0; float ps1 = 0.f, ps2 = 0.f;
#pragma unroll
                for (int bj = 0; bj < 2; ++bj) { f32x4 v0 = acc[ai][bj][m][0] * rs, v1 = acc[ai][bj][m][1] * rs;
                    if (mode == 0) { f32x2 a = gelu_pk((f32x2){v0[0], v0[1]}), b = gelu_pk((f32x2){v0[2], v0[3]}), c = gelu_pk((f32x2){v1[0], v1[1]}), d = gelu_pk((f32x2){v1[2], v1[3]});
                        v0 = (f32x4){a.x, a.y, b.x, b.y}; v1 = (f32x4){c.x, c.y, d.x, d.y}; }
                    else if (mode == 2) {
#pragma unroll
                        for (int j = 0; j < 4; ++j) { v0[j] = sigmoidf_(v0[j]); v1[j] = sigmoidf_(v1[j]); } }
                    u32x4 w; w.x = cvt_pk_bf16(v0[0], v0[1]); w.y = cvt_pk_bf16(v0[2], v0[3]); w.z = cvt_pk_bf16(v1[0], v1[1]); w.w = cvt_pk_bf16(v1[2], v1[3]);
                    *(u32x4*)(rowp + bj * HALF) = w;
                    if (pn >= 4 && pn < 8) { ps1 += ((v0[0] + v0[1]) + (v0[2] + v0[3])) + ((v1[0] + v1[1]) + (v1[2] + v1[3]));
                        ps2 += ((v0[0] * v0[0] + v0[1] * v0[1]) + (v0[2] * v0[2] + v0[3] * v0[3])) + ((v1[0] * v1[0] + v1[1] * v1[1]) + (v1[2] * v1[2] + v1[3] * v1[3])); } }
                if (pn >= 4 && pn < 8) { ps1 += __shfl_xor(ps1, 16); ps1 += __shfl_xor(ps1, 32); ps2 += __shfl_xor(ps2, 16); ps2 += __shfl_xor(ps2, 32);
                    if (fq == 0) { f32x2 o; o.x = ps1; o.y = ps2; *(f32x2*)(part + ((size_t)row * 16 + (pn - 4) * 4 + wc) * 2) = o; } } }
    }
};
template <int SECOND> struct EpiProj {
    static constexpr bool PERM = true, AFTER_DRAIN = false;
    bf16_t* MG; const bf16_t* SGB;
    __device__ __forceinline__ void operator()(const f32x4 (&acc)[2][2][4][2], const Unit& u, int wr, int wc, int fr, int fq) const {
        const int row0 = u.pm * BM + wr * 64 + fr, col0 = u.pn * BM + wc * 32 + 8 * fq;
#pragma unroll
        for (int ai = 0; ai < 2; ++ai)
#pragma unroll
            for (int bj = 0; bj < 2; ++bj) { u32x4 mgv[4], sgv[4];
#pragma unroll
                for (int m = 0; m < 4; ++m) { const size_t off = (size_t)(row0 + ai * HALF + m * 16) * DM + col0 + bj * HALF; mgv[m] = *(const u32x4*)(MG + off); if (SECOND) sgv[m] = *(const u32x4*)(SGB + off); }
#pragma unroll
                for (int m = 0; m < 4; ++m) { const size_t off = (size_t)(row0 + ai * HALF + m * 16) * DM + col0 + bj * HALF; const f32x4 a0 = acc[ai][bj][m][0], a1 = acc[ai][bj][m][1];
                    const u32x4 mg = mgv[m]; float o[8];
                    if (SECOND) { const u32x4 sg = sgv[m];
                        o[0] = bflo(mg.x) + bflo(sg.x) * a0[0]; o[1] = bfhi(mg.x) + bfhi(sg.x) * a0[1]; o[2] = bflo(mg.y) + bflo(sg.y) * a0[2]; o[3] = bfhi(mg.y) + bfhi(sg.y) * a0[3];
                        o[4] = bflo(mg.z) + bflo(sg.z) * a1[0]; o[5] = bfhi(mg.z) + bfhi(sg.z) * a1[1]; o[6] = bflo(mg.w) + bflo(sg.w) * a1[2]; o[7] = bfhi(mg.w) + bfhi(sg.w) * a1[3]; }
                    else { o[0] = bflo(mg.x) * a0[0]; o[1] = bfhi(mg.x) * a0[1]; o[2] = bflo(mg.y) * a0[2]; o[3] = bfhi(mg.y) * a0[3];
                        o[4] = bflo(mg.z) * a1[0]; o[5] = bfhi(mg.z) * a1[1]; o[6] = bflo(mg.w) * a1[2]; o[7] = bfhi(mg.w) * a1[3]; }
                    u32x4 w; w.x = cvt_pk_bf16(o[0], o[1]); w.y = cvt_pk_bf16(o[2], o[3]); w.z = cvt_pk_bf16(o[4], o[5]); w.w = cvt_pk_bf16(o[6], o[7]);
                    *(u32x4*)(MG + off) = w; } }
    }
};
struct EpiOut {
    static constexpr bool PERM = true, AFTER_DRAIN = false;
    const float* X; bf16_t* X1B;
    __device__ __forceinline__ void operator()(const f32x4 (&acc)[2][2][4][2], const Unit& u, int wr, int wc, int fr, int fq) const {
        const int row0 = u.pm * BM + wr * 64 + fr, col0 = u.pn * BM + wc * 32 + 8 * fq;
#pragma unroll
        for (int ai = 0; ai < 2; ++ai)
#pragma unroll
            for (int m = 0; m < 4; ++m) { const size_t off = (size_t)(row0 + ai * HALF + m * 16) * DM + col0;
#pragma unroll
                for (int bj = 0; bj < 2; ++bj) { const f32x4 x0 = *(const f32x4*)(X + off + bj * HALF), x1 = *(const f32x4*)(X + off + bj * HALF + 4);
                    const f32x4 o0 = x0 + acc[ai][bj][m][0], o1 = x1 + acc[ai][bj][m][1];
                    u32x4 w; w.x = cvt_pk_bf16(o0[0], o0[1]); w.y = cvt_pk_bf16(o0[2], o0[3]); w.z = cvt_pk_bf16(o1[0], o1[1]); w.w = cvt_pk_bf16(o1[2], o1[3]);
                    *(u32x4*)(X1B + off + bj * HALF) = w; } }
    }
};
struct EpiGate {
    static constexpr bool PERM = true, AFTER_DRAIN = false;
    bf16_t* GT; const float* rstd;
    __device__ __forceinline__ void operator()(const f32x4 (&acc)[2][2][4][2], const Unit& u, int wr, int wc, int fr, int fq) const {
        const int row0 = u.pm * BM + wr * 64 + fr, col0 = u.pn * BM + wc * 32 + 8 * fq;
#pragma unroll
        for (int ai = 0; ai < 2; ++ai)
#pragma unroll
            for (int m = 0; m < 4; ++m) { const int row = row0 + ai * HALF + m * 16; const float rs = rstd[row]; bf16_t* rowp = GT + (size_t)row * DFF + col0;
#pragma unroll
                for (int bj = 0; bj < 2; ++bj) { const f32x4 v0 = acc[ai][bj][m][0] * rs, v1 = acc[ai][bj][m][1] * rs;
                    u32x4 w; w.x = cvt_pk_bf16(v0[0], v0[1]); w.y = cvt_pk_bf16(v0[2], v0[3]); w.z = cvt_pk_bf16(v1[0], v1[1]); w.w = cvt_pk_bf16(v1[2], v1[3]);
                    *(u32x4*)(rowp + bj * HALF) = w; } }
    }
};
struct EpiUp {
    static constexpr bool PERM = true, AFTER_DRAIN = false;
    const bf16_t* GT; bf16_t* A3; const float *rstd, *cw, *cb;
    __device__ __forceinline__ void operator()(const f32x4 (&acc)[2][2][4][2], const Unit& u, int wr, int wc, int fr, int fq) const {
        const int row0 = u.pm * BM + wr * 64 + fr, colb = u.pn * BM + wc * 32 + 8 * fq;
        float rsv[2][4];
#pragma unroll
        for (int ai = 0; ai < 2; ++ai)
#pragma unroll
            for (int m = 0; m < 4; ++m) rsv[ai][m] = rstd[row0 + ai * HALF + m * 16];
        u32x4 gcA[4], gcB[4], gbA, gbB, gaA, gaB;
#define EU_LOAD(S, GC, GBF, GAF) do { const int bj_ = (S) >> 1, ai_ = (S) & 1; const int col_ = colb + bj_ * HALF; _Pragma("unroll") for (int m = 0; m < 4; ++m) GC[m] = *(const u32x4*)(GT + (size_t)(row0 + ai_ * HALF + m * 16) * DFF + col_); \
            int rb_ = row0 + ai_ * HALF - (fr == 0 ? 1 : 0); rb_ = rb_ < 0 ? 0 : rb_; int ra_ = row0 + ai_ * HALF + 48 + (fr == 15 ? 1 : 0); ra_ = ra_ > MTOK - 1 ? MTOK - 1 : ra_; \
            GBF = *(const u32x4*)(GT + (size_t)rb_ * DFF + col_); GAF = *(const u32x4*)(GT + (size_t)ra_ * DFF + col_); } while (0)
        EU_LOAD(0, gcA, gbA, gaA);
        float w0[8], w1[8], w2[8], bb[8];
#pragma unroll
        for (int s = 0; s < 4; ++s) { const int bj = s >> 1, ai = s & 1; const int col = colb + bj * HALF;
            if (ai == 0) {
#pragma unroll
                for (int h = 0; h < 2; ++h) { const f32x4 a = *(const f32x4*)(cw + col + 4 * h), b = *(const f32x4*)(cw + DFF + col + 4 * h), c = *(const f32x4*)(cw + 2 * DFF + col + 4 * h), d = *(const f32x4*)(cb + col + 4 * h);
#pragma unroll
                    for (int j = 0; j < 4; ++j) { w0[4 * h + j] = a[j]; w1[4 * h + j] = b[j]; w2[4 * h + j] = c[j]; bb[4 * h + j] = d[j]; } } }
            if (s >= 1 && s + 1 < 4) { if (s & 1) EU_LOAD(s + 1, gcA, gbA, gaA); else EU_LOAD(s + 1, gcB, gbB, gaB); }
            const bool zlo = ((row0 + ai * HALF) & (SEQ - 1)) == 0, zhi = ((row0 + ai * HALF + 48) & (SEQ - 1)) == SEQ - 1;
#pragma unroll
            for (int m = 0; m < 4; ++m) { const int row = row0 + ai * HALF + m * 16; const float rs = rsv[ai][m];
                const u32x4 gc = (s & 1) ? gcB[m] : gcA[m]; u32x4 gm, gx;
#pragma unroll
                for (int q = 0; q < 4; ++q) { gm[q] = (unsigned)__builtin_amdgcn_update_dpp(0, (int)gc[q], 0x111, 0xF, 0xF, true); gx[q] = (unsigned)__builtin_amdgcn_update_dpp(0, (int)gc[q], 0x101, 0xF, 0xF, true);
                    unsigned em, ex;
                    if (m == 0) em = zlo ? 0u : ((s & 1) ? gbB[q] : gbA[q]); else em = (unsigned)__builtin_amdgcn_update_dpp(0, (int)((s & 1) ? gcB[m - 1][q] : gcA[m - 1][q]), 0x121, 0xF, 0xF, true);
                    if (m == 3) ex = zhi ? 0u : ((s & 1) ? gaB[q] : gaA[q]); else ex = (unsigned)__builtin_amdgcn_update_dpp(0, (int)((s & 1) ? gcB[m + 1][q] : gcA[m + 1][q]), 0x12F, 0xF, 0xF, true);
                    if (fr == 0) gm[q] = em;
                    if (fr == 15) gx[q] = ex; }
                u32x4 w;
#pragma unroll
                for (int p = 0; p < 4; ++p) { const unsigned cm = gm[p], cc = gc[p], cx = gx[p];
                    const f32x2 fm = {bflo(cm), bfhi(cm)}, fc = {bflo(cc), bfhi(cc)}, fx = {bflo(cx), bfhi(cx)};
                    const f32x2 k0 = {w0[2 * p], w0[2 * p + 1]}, k1 = {w1[2 * p], w1[2 * p + 1]}, k2 = {w2[2 * p], w2[2 * p + 1]}, kb = {bb[2 * p], bb[2 * p + 1]};
                    const f32x2 gt = k0 * fm + (k1 * fc + (k2 * fx + kb));
                    const f32x2 ex2 = gt * (-1.44269504089f); f32x2 den; den.x = __builtin_amdgcn_exp2f(ex2.x); den.y = __builtin_amdgcn_exp2f(ex2.y); den = den + 1.0f;
                    f32x2 sg; sg.x = __builtin_amdgcn_rcpf(den.x); sg.y = __builtin_amdgcn_rcpf(den.y);
                    const f32x2 av = {acc[ai][bj][m][p >> 1][(2 * p) & 3], acc[ai][bj][m][p >> 1][((2 * p) & 3) + 1]};
                    const f32x2 o = (gt * sg) * (av * rs);
                    w[p] = cvt_pk_bf16(o.x, o.y); }
                *(u32x4*)(A3 + (size_t)row * DFF + col) = w; }
            if (s == 0) EU_LOAD(1, gcB, gbB, gaB); }
#undef EU_LOAD
    }
};
struct EpiDown {
    static constexpr bool PERM = true, AFTER_DRAIN = false;
    float* X1;
    __device__ __forceinline__ void operator()(const f32x4 (&acc)[2][2][4][2], const Unit& u, int wr, int wc, int fr, int fq) const {
        const int row0 = u.pm * BM + wr * 64 + fr, col0 = u.pn * BM + wc * 32 + 8 * fq;
#pragma unroll
        for (int ai = 0; ai < 2; ++ai)
#pragma unroll
            for (int m = 0; m < 4; ++m) { const size_t off = (size_t)(row0 + ai * HALF + m * 16) * DM + col0;
#pragma unroll
                for (int bj = 0; bj < 2; ++bj) { const f32x4 x0 = *(const f32x4*)(X1 + off + bj * HALF), x1 = *(const f32x4*)(X1 + off + bj * HALF + 4);
                    *(f32x4*)(X1 + off + bj * HALF) = x0 + acc[ai][bj][m][0]; *(f32x4*)(X1 + off + bj * HALF + 4) = x1 + acc[ai][bj][m][1]; } }
    }
};
struct EpiOutNorm {
    static constexpr bool PERM = true, AFTER_DRAIN = true;
    const float* X; bf16_t* X1B; float* rstd2; float* xbuf; unsigned* cnt;
    __device__ __forceinline__ void fused(f32x4 (&acc)[2][2][4][2], const Unit& u, int wr, int wc, int fr, int fq, PG8_LAS unsigned char* lds, int wid, int lane) const {
        PG8_LAS float* P = (PG8_LAS float*)lds;
        const int row0 = u.pm * BM + wr * 64 + fr, col0 = u.pn * BM + wc * 32 + 8 * fq;
#pragma unroll
        for (int ai = 0; ai < 2; ++ai) { f32x4 xv[4][2][2];
#pragma unroll
            for (int m = 0; m < 4; ++m)
#pragma unroll
                for (int bj = 0; bj < 2; ++bj) { const size_t off = (size_t)(row0 + ai * HALF + m * 16) * DM + col0 + bj * HALF; xv[m][bj][0] = *(const f32x4*)(X + off); xv[m][bj][1] = *(const f32x4*)(X + off + 4); }
#pragma unroll
            for (int m = 0; m < 4; ++m) { const size_t off = (size_t)(row0 + ai * HALF + m * 16) * DM + col0; float q = 0.f;
#pragma unroll
                for (int bj = 0; bj < 2; ++bj) { const f32x4 o0 = xv[m][bj][0] + acc[ai][bj][m][0], o1 = xv[m][bj][1] + acc[ai][bj][m][1];
                    u32x4 w; w.x = cvt_pk_bf16(o0[0], o0[1]); w.y = cvt_pk_bf16(o0[2], o0[3]); w.z = cvt_pk_bf16(o1[0], o1[1]); w.w = cvt_pk_bf16(o1[2], o1[3]);
                    *(u32x4*)(X1B + off + bj * HALF) = w;
#pragma unroll
                    for (int e = 0; e < 4; ++e) { const float lo = bflo(w[e]), hi = bfhi(w[e]); q += lo * lo + hi * hi; } }
                q += __shfl_xor(q, 16); q += __shfl_xor(q, 32);
                if (fq == 0) P[(ai * HALF + wr * 64 + m * 16 + fr) * 4 + wc] = q; } }
        asm volatile("s_waitcnt lgkmcnt(0)" ::: "memory"); __builtin_amdgcn_s_barrier(); asm volatile("" ::: "memory");
        const int row = wid * 32 + (lane & 31);
        if (lane < 32) { const float t = (P[row * 4 + 0] + P[row * 4 + 1]) + (P[row * 4 + 2] + P[row * 4 + 3]);
            __hip_atomic_store(xbuf + (size_t)(u.pm * BM + row) * 8 + u.pn, t, __ATOMIC_RELAXED, __HIP_MEMORY_SCOPE_AGENT); }
        asm volatile("s_waitcnt vmcnt(0)" ::: "memory");
        if (lane == 0) __hip_atomic_fetch_add(cnt + 64 * u.pm, 1u, __ATOMIC_RELAXED, __HIP_MEMORY_SCOPE_AGENT);
        if (u.pn == 0) {
            if (wid == 0) { unsigned spins = 0;
                while ((unsigned)__builtin_amdgcn_readfirstlane(__hip_atomic_load(cnt + 64 * u.pm, __ATOMIC_RELAXED, __HIP_MEMORY_SCOPE_AGENT)) < 64u) { __builtin_amdgcn_s_sleep(2); if (++spins > (1u << 22)) break; }
                __builtin_amdgcn_fence(__ATOMIC_ACQUIRE, "agent"); }
            asm volatile("s_waitcnt vmcnt(0) lgkmcnt(0)" ::: "memory"); __builtin_amdgcn_s_barrier(); asm volatile("" ::: "memory");
            if (lane < 32) { const float* sl = xbuf + (size_t)(u.pm * BM + row) * 8; float t = 0.f;
#pragma unroll
                for (int q = 0; q < 8; ++q) t += __hip_atomic_load(sl + q, __ATOMIC_RELAXED, __HIP_MEMORY_SCOPE_AGENT);
                rstd2[u.pm * BM + row] = 1.0f / sqrtf(t * (1.0f / DM) + 1e-6f); } }
    }
};
struct EpiDownNorm {
    static constexpr bool PERM = true, AFTER_DRAIN = true;
    const bf16_t* X1B; float* OUT; const float* gf; float* xbuf; unsigned* cnt;
    __device__ __forceinline__ void fused(f32x4 (&acc)[2][2][4][2], const Unit& u, int wr, int wc, int fr, int fq, PG8_LAS unsigned char* lds, int wid, int lane) const {
        PG8_LAS float* P = (PG8_LAS float*)lds;
        PG8_LAS float* S = (PG8_LAS float*)(lds + 8192);
        const int row0 = u.pm * BM + wr * 64 + fr, col0 = u.pn * BM + wc * 32 + 8 * fq;
#pragma unroll
        for (int ai = 0; ai < 2; ++ai) { u32x4 xwv[4][2];
#pragma unroll
            for (int m = 0; m < 4; ++m)
#pragma unroll
                for (int bj = 0; bj < 2; ++bj) xwv[m][bj] = *(const u32x4*)(X1B + (size_t)(row0 + ai * HALF + m * 16) * DM + col0 + bj * HALF);
#pragma unroll
            for (int m = 0; m < 4; ++m)
#pragma unroll
                for (int bj = 0; bj < 2; ++bj) { const u32x4 xw = xwv[m][bj];
                    acc[ai][bj][m][0] += (f32x4){bflo(xw.x), bfhi(xw.x), bflo(xw.y), bfhi(xw.y)}; acc[ai][bj][m][1] += (f32x4){bflo(xw.z), bfhi(xw.z), bflo(xw.w), bfhi(xw.w)}; } }
#pragma unroll
        for (int ai = 0; ai < 2; ++ai)
#pragma unroll
            for (int m = 0; m < 4; ++m) { float q = 0.f;
#pragma unroll
                for (int bj = 0; bj < 2; ++bj)
#pragma unroll
                    for (int n = 0; n < 2; ++n) { const f32x4 x = acc[ai][bj][m][n]; q += (x[0] * x[0] + x[1] * x[1]) + (x[2] * x[2] + x[3] * x[3]); }
                q += __shfl_xor(q, 16); q += __shfl_xor(q, 32);
                if (fq == 0) P[(ai * HALF + wr * 64 + m * 16 + fr) * 4 + wc] = q; }
        asm volatile("s_waitcnt lgkmcnt(0)" ::: "memory"); __builtin_amdgcn_s_barrier(); asm volatile("" ::: "memory");
        const int row = wid * 32 + (lane & 31);
        if (lane < 32) { const float t = (P[row * 4 + 0] + P[row * 4 + 1]) + (P[row * 4 + 2] + P[row * 4 + 3]);
            __hip_atomic_store(xbuf + (size_t)(u.pm * BM + row) * 8 + u.pn, t, __ATOMIC_RELAXED, __HIP_MEMORY_SCOPE_AGENT); }
        asm volatile("s_waitcnt vmcnt(0)" ::: "memory");
        if (lane == 0) __hip_atomic_fetch_add(cnt + 64 * u.pm, 1u, __ATOMIC_RELAXED, __HIP_MEMORY_SCOPE_AGENT);
        if (wid == 0) { unsigned spins = 0;
            while ((unsigned)__builtin_amdgcn_readfirstlane(__hip_atomic_load(cnt + 64 * u.pm, __ATOMIC_RELAXED, __HIP_MEMORY_SCOPE_AGENT)) < 64u) { __builtin_amdgcn_s_sleep(2); if (++spins > (1u << 22)) break; }
            __builtin_amdgcn_fence(__ATOMIC_ACQUIRE, "agent"); }
        asm volatile("s_waitcnt vmcnt(0) lgkmcnt(0)" ::: "memory"); __builtin_amdgcn_s_barrier(); asm volatile("" ::: "memory");
        if (lane < 32) { const float* sl = xbuf + (size_t)(u.pm * BM + row) * 8; float t = 0.f;
#pragma unroll
            for (int q = 0; q < 8; ++q) t += __hip_atomic_load(sl + q, __ATOMIC_RELAXED, __HIP_MEMORY_SCOPE_AGENT);
            S[row] = 1.0f / sqrtf(t * (1.0f / DM) + 1e-6f); }
        asm volatile("s_waitcnt lgkmcnt(0)" ::: "memory"); __builtin_amdgcn_s_barrier(); asm volatile("" ::: "memory");
#pragma unroll
        for (int bj = 0; bj < 2; ++bj) { const f32x4 g0 = *(const f32x4*)(gf + col0 + bj * HALF), g1 = *(const f32x4*)(gf + col0 + bj * HALF + 4);
#pragma unroll
            for (int ai = 0; ai < 2; ++ai)
#pragma unroll
                for (int m = 0; m < 4; ++m) { const int r = ai * HALF + wr * 64 + m * 16 + fr; const float rs = S[r]; const size_t off = (size_t)(u.pm * BM + r) * DM + col0 + bj * HALF;
                    *(f32x4*)(OUT + off) = acc[ai][bj][m][0] * rs * g0; *(f32x4*)(OUT + off + 4) = acc[ai][bj][m][1] * rs * g1; } }
    }
};
}

#define XB_TMO      128
#define XB_XCNT(j)  (256  + 64 * (j))
#define XB_XSUB(j)  (1280 + 64 * (j))
#define XB_XGEN(j)  (2304 + 64 * (j))
#define XB_TOP      3328
#define XB_TOPGEN   3392
#define XCD_BAR_WORDS 3456
#define XB_SPIN_CAP (1u << 18)

__device__ __forceinline__ unsigned xb_ld(unsigned* p)              { return __hip_atomic_load(p, __ATOMIC_RELAXED, __HIP_MEMORY_SCOPE_AGENT); }
__device__ __forceinline__ unsigned xb_add(unsigned* p, unsigned v) { return __hip_atomic_fetch_add(p, v, __ATOMIC_RELAXED, __HIP_MEMORY_SCOPE_AGENT); }
__device__ __forceinline__ unsigned xb_xcc_id() { return (unsigned)__builtin_amdgcn_s_getreg((3 << 11) | 20) & 0xFu; }
#define XB_SPIN(cond, bar) do { unsigned _sp = 0; while (cond) { __builtin_amdgcn_s_sleep(1); \
    if ((++_sp & 255u) == 0u) { if (xb_ld(&(bar)[XB_TMO])) break; if (_sp > XB_SPIN_CAP) { atomicAdd(&(bar)[XB_TMO], 1u); break; } } } } while (0)

struct XcdBarrier {
    unsigned* bar; unsigned x;
    volatile LAS unsigned* st;
};

__device__ __forceinline__ XcdBarrier xcd_barrier_post(unsigned* bar, volatile LAS unsigned* st) {
    XcdBarrier b; b.bar = bar; b.x = xb_xcc_id(); b.st = st;
    if (threadIdx.x == 0) (void)xb_add(&bar[XB_XCNT(b.x)], 1u);
    return b;
}
__device__ __forceinline__ void xcd_barrier_complete(unsigned* bar, unsigned x, unsigned& nloc, unsigned& nx) {
    const unsigned G = gridDim.x * gridDim.y * gridDim.z;
    unsigned sum, cnt, mine, sp = 0u;
    for (;;) {
        sum = 0u; cnt = 0u; mine = 0u;
#pragma unroll
        for (unsigned j = 0; j < 16; ++j) { const unsigned c = xb_ld(&bar[XB_XCNT(j)]); sum += c; cnt += (c > 0u) ? 1u : 0u; mine = (j == x) ? c : mine; }
        if (sum == G) break;
        __builtin_amdgcn_s_sleep(1);
        if ((++sp & 255u) == 0u) { if (xb_ld(&bar[XB_TMO])) break; if (sp > XB_SPIN_CAP) { atomicAdd(&bar[XB_TMO], 1u); break; } }
    }
    nloc = mine > 0u ? mine : 1u; nx = cnt > 0u ? cnt : 1u;
}

__device__ __forceinline__ void xcd_barrier(const XcdBarrier& b) {
    asm volatile("s_waitcnt vmcnt(0)" ::: "memory");
    __syncthreads();
    if (threadIdx.x == 0) {
        unsigned* bar = b.bar;
        __builtin_amdgcn_s_waitcnt(0);
        unsigned nloc = b.st[0], nx = b.st[1];
        if (nloc == 0u) { xcd_barrier_complete(bar, b.x, nloc, nx); b.st[0] = nloc; b.st[1] = nx; }
        const unsigned old = xb_add(&bar[XB_XSUB(b.x)], 1u);
        const unsigned gen = old / nloc;
        if (old + 1u == (gen + 1u) * nloc) {
            __builtin_amdgcn_fence(__ATOMIC_RELEASE, "agent");
            asm volatile("s_waitcnt vmcnt(0)" ::: "memory");
            const unsigned og = xb_add(&bar[XB_TOP], 1u);
            const unsigned tg = og / nx;
            if (og + 1u == (tg + 1u) * nx) xb_add(&bar[XB_TOPGEN], 1u);
            else XB_SPIN(xb_ld(&bar[XB_TOPGEN]) == tg, bar);
            __builtin_amdgcn_fence(__ATOMIC_ACQUIRE, "agent");
            xb_add(&bar[XB_XGEN(b.x)], 1u);
            asm volatile("s_waitcnt vmcnt(0)" ::: "memory");
        } else {
            XB_SPIN(xb_ld(&bar[XB_XGEN(b.x)]) == gen, bar);
            __builtin_amdgcn_fence(__ATOMIC_ACQUIRE, "agent");
            asm volatile("s_waitcnt vmcnt(0)" ::: "memory");
        }
    }
    __syncthreads();
}

struct Args { const float* in[33]; float* out; unsigned char* ws; int ph_lo, ph_hi; };
enum { I_X = 0, I_N1G, I_WIN, I_SLNG, I_SLNB, I_SW, I_SB, I_MUP, I_MUN, I_W0F, I_W2F, I_A0F, I_A2F, I_W0B, I_W2B, I_A0B, I_A2B, I_KK, I_KA, I_RK, I_G2, I_GNG, I_GNB,
       I_WPA, I_WPB, I_WOUT, I_N2G, I_WGATE, I_WUP, I_CW, I_CB, I_WDOWN, I_NFG };

struct TpDesc { const float* W; bf16* WT; const float* ksc; int K, N, drow0, k0, n0; };
__device__ __forceinline__ void tp_load(const TpDesc& d, int lane, float (&vv)[32], float (&sc)[32]) {
#pragma unroll
    for (int i = 0; i < 32; ++i) { const int kk = 2 * i + (lane >> 5); vv[i] = __builtin_nontemporal_load(d.W + ((size_t)(d.k0 + kk) * d.N + d.n0 + (lane & 31))); }
#pragma unroll
    for (int i = 0; i < 32; ++i) sc[i] = d.ksc ? d.ksc[d.k0 + 2 * i + (lane >> 5)] : 1.0f;
}
template <bool NTS> __device__ __forceinline__ void tp_store(const TpDesc& d, LAS float* scr, int lane, const float (&vv)[32], const float (&sc)[32]) {
#pragma unroll
    for (int i = 0; i < 32; ++i) { const int kk = 2 * i + (lane >> 5); scr[kk * 33 + (lane & 31)] = vv[i] * sc[i]; }
    LDS_WAIT(); asm volatile("" ::: "memory");
    const int c = lane & 7;
#pragma unroll
    for (int j = 0; j < 4; ++j) { const int n = (lane >> 3) + 8 * j; const LAS float* s = scr + (8 * c) * 33 + n;
        v4u o; o.x = pk2(s[0 * 33], s[1 * 33]); o.y = pk2(s[2 * 33], s[3 * 33]); o.z = pk2(s[4 * 33], s[5 * 33]); o.w = pk2(s[6 * 33], s[7 * 33]);
        if (NTS) __builtin_nontemporal_store(o, (v4u*)(d.WT + (size_t)(d.drow0 + n) * d.K + d.k0 + 8 * c)); else *(v4u*)(d.WT + (size_t)(d.drow0 + n) * d.K + d.k0 + 8 * c) = o; }
    LDS_WAIT(); asm volatile("" ::: "memory");
}
template <int SEL> __device__ __forceinline__ void tp_decode(const Args& a, int it, TpDesc& d) {
    unsigned char* ws = a.ws;
    if (SEL == 0) { const int nblk = INW / 32, kb = it / nblk, nb = it % nblk, n0 = 32 * nb; d = TpDesc{a.in[I_WIN], (bf16*)(ws + WS_WIN), a.in[I_N1G], DM, INW, n0 < 5536 ? n0 : n0 + 96, 64 * kb, n0}; }
    else if (SEL == 3) { constexpr int I_PA = (SGW / 64) * (DM / 32), I_PB = I_PA; int r = it;
        if (r < I_PA) { const int nblk = DM / 32, kb = r / nblk, nb = r % nblk; d = TpDesc{a.in[I_WPA], (bf16*)(ws + WS_WPA), nullptr, SGW, DM, 32 * nb, 64 * kb, 32 * nb}; return; } r -= I_PA;
        if (r < I_PB) { const int nblk = DM / 32, kb = r / nblk, nb = r % nblk; d = TpDesc{a.in[I_WPB], (bf16*)(ws + WS_WPB), nullptr, RWW, DM, 32 * nb, 64 * kb, 32 * nb}; return; } r -= I_PB;
        { const int nblk = DM / 32, kb = r / nblk, nb = r % nblk; d = TpDesc{a.in[I_WOUT], (bf16*)(ws + WS_WOUT), nullptr, DM, DM, 32 * nb, 64 * kb, 32 * nb}; } }
    else if (SEL == 1) { constexpr int I_G = (DM / 64) * (DFF / 32); int r = it; const bool up = r >= I_G; if (up) r -= I_G; const int nblk = DFF / 32, kb = r / nblk, nb = r % nblk;
        d = TpDesc{up ? a.in[I_WUP] : a.in[I_WGATE], (bf16*)(ws + (up ? WS_WU : WS_WG)), a.in[I_N2G], DM, DFF, 32 * nb, 64 * kb, 32 * nb}; }
    else { const int nblk = DM / 32, kb = it / nblk, nb = it % nblk; d = TpDesc{a.in[I_WDOWN], (bf16*)(ws + WS_WD), nullptr, DFF, DM, 32 * nb, 64 * kb, 32 * nb}; }
}
template <int SEL> __device__ __forceinline__ void tp_run(const Args& a, LAS float* scr, int lane, int first, int end, int step) {
    float va[32], sa[32], vb[32], sb[32]; TpDesc da, db;
    int it = first; if (it >= end) return;
    tp_decode<SEL>(a, it, da); tp_load(da, lane, va, sa);
    for (;;) {
        const int n1 = it + step; const bool h1 = n1 < end;
        if (h1) { tp_decode<SEL>(a, n1, db); tp_load(db, lane, vb, sb); }
        tp_store<SEL == 2>(da, scr, lane, va, sa);
        if (!h1) break;
        it = n1 + step; const bool h2 = it < end;
        if (h2) { tp_decode<SEL>(a, it, da); tp_load(da, lane, va, sa); }
        tp_store<SEL == 2>(db, scr, lane, vb, sb);
        if (!h2) break;
    }
}
__device__ __forceinline__ void phase_ffn_weights(const Args& a, LAS unsigned char* lds, int G) {
    const int tid = threadIdx.x, lane = tid & 63, wave = tid >> 6;
    constexpr int I_G = (DM / 64) * (DFF / 32);
    tp_run<1>(a, (LAS float*)(lds + wave * 16384), lane, blockIdx.x * NWAVES + wave, I_G, G * NWAVES);
}
__device__ __forceinline__ void convert_wup_tail(const Args& a, LAS unsigned char* lds, int nb_, int b0_) {
    const int tid = threadIdx.x, lane = tid & 63, wave = tid >> 6;
    constexpr int I_G = (DM / 64) * (DFF / 32);
    tp_run<1>(a, (LAS float*)(lds + wave * 16384), lane, I_G + ((int)blockIdx.x - b0_) * NWAVES + wave, 2 * I_G, nb_ * NWAVES);
}
__device__ __forceinline__ void convert_wdown_half(const Args& a, LAS unsigned char* lds, int half, int nb_, int b0_) {
    const int tid = threadIdx.x, lane = tid & 63, wave = tid >> 6;
    constexpr int I_D = (DFF / 64) * (DM / 32);
    if (half < 0) tp_run<2>(a, (LAS float*)(lds + wave * 16384), lane, ((int)blockIdx.x - b0_) * NWAVES + wave, I_D, nb_ * NWAVES);
    else tp_run<2>(a, (LAS float*)(lds + wave * 16384), lane, half * (I_D / 2) + ((int)blockIdx.x - b0_) * NWAVES + wave, (half + 1) * (I_D / 2), nb_ * NWAVES);
}
__device__ __forceinline__ void convert_small_weights(const Args& a, LAS unsigned char* lds, int nb_, int b0_) {
    const int tid = threadIdx.x, lane = tid & 63, wave = tid >> 6; unsigned char* ws = a.ws; const int G = nb_;
    tp_run<3>(a, (LAS float*)(lds + wave * 16384), lane, ((int)blockIdx.x - b0_) * NWAVES + wave, 2 * (SGW / 64) * (DM / 32) + (DM / 64) * (DM / 32), nb_ * NWAVES);
    { bf16* w2t = (bf16*)(ws + WS_W2T); const int gt_ = ((int)blockIdx.x - b0_) * NTHR + tid, nt_ = G * NTHR;
      for (int base = gt_; base < 416 * RWW; base += 4 * nt_) { float v[4];
#pragma unroll
          for (int u = 0; u < 4; ++u) { const int idx = base + u * nt_; v[u] = 0.f; if (idx < 416 * RWW) { const int j = idx >> 10, c = idx & 1023;
              v[u] = j < 64 ? a.in[I_W2F][(size_t)j * RWW + c] : j < 128 ? a.in[I_W2B][(size_t)(j - 64) * RWW + c] : j < 192 ? a.in[I_A2F][(size_t)(j - 128) * RWW + c] : j < 256 ? a.in[I_A2B][(size_t)(j - 192) * RWW + c] : a.in[I_G2][(size_t)(j - 256) * RWW + c]; } }
#pragma unroll
          for (int u = 0; u < 4; ++u) { const int idx = base + u * nt_; if (idx < 416 * RWW) { const int j = idx >> 10, c = idx & 1023;
              w2t[((size_t)((c >> 5) * 26 + (j >> 4)) * 64 + ((j >> 3) & 1) * 32 + (c & 31)) * 8 + (j & 7)] = (bf16)f2bf(v[u]); } } } }
}
__device__ __forceinline__ void phase_prologue(const Args& a, LAS unsigned char* lds, int G) {
    const int tid = threadIdx.x, lane = tid & 63, wave = tid >> 6;
    LAS float* scr = (LAS float*)(lds + wave * 16384);
    const int gw = blockIdx.x * NWAVES + wave, NGW = G * NWAVES;
    unsigned char* ws = a.ws;
    tp_run<0>(a, scr, lane, gw, (DM / 64) * (INW / 32), NGW);
    { v4u* z = (v4u*)((bf16*)(ws + WS_WIN) + (size_t)5536 * DM); const int nz = 96 * DM * 2 / 16;
      for (int i = blockIdx.x * NTHR + tid; i < nz; i += G * NTHR) z[i] = (v4u){0u, 0u, 0u, 0u}; }
    const float* x = a.in[I_X]; bf16* xb = (bf16*)(ws + WS_XB); float* rstd1 = (float*)(ws + WS_RSTD1);
    for (int m = gw; m < MTOK; m += 2 * NGW) { const int m1 = m + NGW; const bool h1 = m1 < MTOK;
        const f32x4* xr0 = (const f32x4*)(x + (size_t)m * DM) + lane; const f32x4* xr1 = (const f32x4*)(x + (size_t)(h1 ? m1 : m) * DM) + lane; f32x4 v0[8], v1[8]; float s0 = 0.f, s1 = 0.f;
#pragma unroll
        for (int j = 0; j < 8; ++j) { v0[j] = __builtin_nontemporal_load(xr0 + 64 * j); v1[j] = __builtin_nontemporal_load(xr1 + 64 * j); }
#pragma unroll
        for (int j = 0; j < 8; ++j) { s0 += (v0[j].x * v0[j].x + v0[j].y * v0[j].y) + (v0[j].z * v0[j].z + v0[j].w * v0[j].w); s1 += (v1[j].x * v1[j].x + v1[j].y * v1[j].y) + (v1[j].z * v1[j].z + v1[j].w * v1[j].w); }
        s0 = wave_sum(s0); s1 = wave_sum(s1);
        if (lane == 0) { rstd1[m] = 1.0f / sqrtf(s0 * (1.0f / DM) + NORM_EPS); if (h1) rstd1[m1] = 1.0f / sqrtf(s1 * (1.0f / DM) + NORM_EPS); }
        unsigned long long* o0 = (unsigned long long*)(xb + (size_t)m * DM) + lane; unsigned long long* o1 = (unsigned long long*)(xb + (size_t)(h1 ? m1 : m) * DM) + lane;
#pragma unroll
        for (int j = 0; j < 8; ++j) { o0[64 * j] = (unsigned long long)pk2(v0[j].x, v0[j].y) | ((unsigned long long)pk2(v0[j].z, v0[j].w) << 32);
            if (h1) o1[64 * j] = (unsigned long long)pk2(v1[j].x, v1[j].y) | ((unsigned long long)pk2(v1[j].z, v1[j].w) << 32); }
    }
}

typedef short bf16x8_t __attribute__((ext_vector_type(8)));
typedef float f32x16 __attribute__((ext_vector_type(16)));
constexpr int SGP = 136;
__device__ __forceinline__ void phase_sgu(const Args& a, LAS unsigned char* lds, int G) {
    const int tid = threadIdx.x, lane = tid & 63, wave = tid >> 6;
    LAS bf16* wimg = (LAS bf16*)lds;
    LAS bf16* vt = (LAS bf16*)(lds + 128 * SGP * 2);
    LAS float* mu = (LAS float*)(lds + 2 * 128 * SGP * 2);
    LAS float* rs = mu + 128;
    const bf16* U = (const bf16*)(a.ws + WS_U); const bf16* VG = (const bf16*)(a.ws + WS_VG); bf16* YA = (bf16*)(a.ws + WS_YA);
    const float* lng = a.in[I_SLNG]; const float* lnb = a.in[I_SLNB]; const float* sw = a.in[I_SW]; const float* sb = a.in[I_SB];
    unsigned long long sq0 = 0, sq1 = 0, sq2 = 0, sql = 0;
#define SGT(ACC) do { if (PROBE_TA != 0) { const unsigned long long n_ = __builtin_amdgcn_s_memrealtime(); ACC += n_ - sql; sql = n_; } } while (0)
    for (int item = blockIdx.x; item < 512; item += G) {
        if (PROBE_TA != 0) sql = __builtin_amdgcn_s_memrealtime();
        const int bc = item >> 3, g = item & 7, m0 = bc * 128;
        v4u vraw[4];
#pragma unroll
        for (int q = 0; q < 4; ++q) { const int it2 = q * 8 + wave; const int j = (it2 & 1) * 64 + lane, dg = it2 >> 1; vraw[q] = *(const v4u*)(VG + (size_t)(m0 + j) * SGW + g * 128 + dg * 8); }
        if (tid < 128) { const f32x4* pp = (const f32x4*)((const float*)(a.ws + WS_PART) + (size_t)(m0 + tid) * 32); float s1 = 0.f, s2 = 0.f;
#pragma unroll
            for (int q = 0; q < 8; ++q) { const f32x4 v = pp[q]; s1 += v.x + v.z; s2 += v.y + v.w; }
            const float mean = s1 * (1.0f / SGW); const float var = fmaxf(s2 * (1.0f / SGW) - mean * mean, 0.f);
            mu[tid] = mean; rs[tid] = 1.0f / sqrtf(var + LN_EPS); }
#pragma unroll
        for (int q = 0; q < 8; ++q) { const int idx = q * NTHR + tid; const int i = idx >> 5, j4 = (idx & 31) * 4; const f32x4 w4 = *(const f32x4*)(sw + (size_t)g * 16384 + i * 128 + j4);
            v2u o; o.x = pk2(w4.x, w4.y); o.y = pk2(w4.z, w4.w); *(LAS v2u*)(wimg + i * SGP + j4) = o; }
        __syncthreads(); SGT(sq0);
#pragma unroll
        for (int q = 0; q < 4; ++q) { const int it2 = q * 8 + wave; const int j = (it2 & 1) * 64 + lane, dg = it2 >> 1; const int ch = g * 128 + dg * 8;
            const v4u raw = vraw[q]; const float mj = mu[j], rj = rs[j];
            const f32x4 g0 = *(const f32x4*)(lng + ch), g1 = *(const f32x4*)(lng + ch + 4), b0 = *(const f32x4*)(lnb + ch), b1 = *(const f32x4*)(lnb + ch + 4);
#pragma unroll
            for (int e = 0; e < 8; ++e) { const unsigned w = raw[e >> 1]; const float x = (e & 1) ? bfhi(w) : bflo(w); const float gg = e < 4 ? g0[e & 3] : g1[e & 3], bb = e < 4 ? b0[e & 3] : b1[e & 3];
                vt[(dg * 8 + e) * SGP + j] = (bf16)f2bf((x - mj) * rj * gg + bb); } }
        __syncthreads(); SGT(sq1);
        const int ti = wave >> 1, tj0 = (wave & 1) * 2, r31 = lane & 31, hh = lane >> 5;
        v4u upc[2][2];
#pragma unroll
        for (int tt = 0; tt < 2; ++tt)
#pragma unroll
            for (int q = 0; q < 2; ++q) { const int idx = lane + 64 * q; upc[tt][q] = *(const v4u*)(U + (size_t)(m0 + 32 * ti + (idx >> 2)) * SGW + g * 128 + 32 * (tj0 + tt) + 8 * (idx & 3)); }
        float sbv[16];
#pragma unroll
        for (int e = 0; e < 16; ++e) sbv[e] = sb[g * 128 + 32 * ti + (e & 3) + 8 * (e >> 2) + 4 * hh];
        f32x16 acc0, acc1;
#pragma unroll
        for (int e = 0; e < 16; ++e) { acc0[e] = 0.f; acc1[e] = 0.f; }
#pragma unroll
        for (int kk = 0; kk < 8; ++kk) {
            const bf16x8_t af = *(const LAS bf16x8_t*)(wimg + (32 * ti + r31) * SGP + 16 * kk + 8 * hh);
            const bf16x8_t b0 = *(const LAS bf16x8_t*)(vt + (32 * tj0 + r31) * SGP + 16 * kk + 8 * hh);
            const bf16x8_t b1 = *(const LAS bf16x8_t*)(vt + (32 * (tj0 + 1) + r31) * SGP + 16 * kk + 8 * hh);
            acc0 = __builtin_amdgcn_mfma_f32_32x32x16_bf16(af, b0, acc0, 0, 0, 0);
            acc1 = __builtin_amdgcn_mfma_f32_32x32x16_bf16(af, b1, acc1, 0, 0, 0); }
        LAS bf16* stg_ = (LAS bf16*)(lds + 2 * 128 * SGP * 2 + 1024 + wave * 2560);
#pragma unroll
        for (int tt = 0; tt < 2; ++tt) {
#pragma unroll
            for (int q = 0; q < 2; ++q) { const int idx = lane + 64 * q; *(LAS v4u*)(stg_ + (idx >> 2) * 40 + 8 * (idx & 3)) = upc[tt][q]; }
            asm volatile("s_waitcnt lgkmcnt(0)" ::: "memory");
            float uv[16];
#pragma unroll
            for (int e = 0; e < 16; ++e) uv[e] = bf2f(stg_[((e & 3) + 8 * (e >> 2) + 4 * hh) * 40 + r31]);
            asm volatile("s_waitcnt lgkmcnt(0)" ::: "memory");
#pragma unroll
            for (int e = 0; e < 16; ++e) { const float mixed = (tt ? acc1[e] : acc0[e]) + sbv[e]; stg_[((e & 3) + 8 * (e >> 2) + 4 * hh) * 40 + r31] = (bf16)f2bf(uv[e] * mixed); }
            asm volatile("s_waitcnt lgkmcnt(0)" ::: "memory");
#pragma unroll
            for (int q = 0; q < 2; ++q) { const int idx = lane + 64 * q; const v4u v = *(const LAS v4u*)(stg_ + (idx >> 2) * 40 + 8 * (idx & 3));
                *(v4u*)(YA + (size_t)(m0 + 32 * ti + (idx >> 2)) * SGW + g * 128 + 32 * (tj0 + tt) + 8 * (idx & 3)) = v; }
            asm volatile("s_waitcnt lgkmcnt(0)" ::: "memory"); }
        __syncthreads(); SGT(sq2);
    }
    if (PROBE_TA != 0 && blockIdx.x == 0 && tid == 0) { unsigned long long* st = (unsigned long long*)(a.ws + WS_CTL + 32768); st[28] = sq0; st[29] = sq1; st[30] = sq2; st[31] = 0; }
}

constexpr int PT = 32;
constexpr int LORA_K = 416;
constexpr int ACTP = 424;
__device__ __forceinline__ float ldbf(const bf16* base, unsigned byte_off) { return bf2f(*(const bf16*)((const char*)base + byte_off)); }
__device__ __forceinline__ void stbf(bf16* base, unsigned byte_off, float v) { *(bf16*)((char*)base + byte_off) = (bf16)f2bf(v); }
__device__ __forceinline__ float shift_mix(float fp, float fc, float fn, float mp, float mn) { return fc + mp * (fp - fc) + mn * (fn - fc); }
constexpr int PRP = 40;
constexpr int PREP_WAVE_LDS = (3 * 34 + 8 * 8) * PRP * 2;
__device__ __forceinline__ void phase_prep(const Args& a, LAS unsigned char* lds, int G) {
    const int tid = threadIdx.x, lane = tid & 63, wave = tid >> 6, r31 = lane & 31, hh = lane >> 5;
    LAS bf16* act = (LAS bf16*)lds;
    LAS bf16* inb = (LAS bf16*)(lds + PT * ACTP * 2 + wave * PREP_WAVE_LDS);
    LAS bf16* outb = inb + 3 * 34 * PRP;
    unsigned char* ws = a.ws;
    const bf16* FT = (const bf16*)(ws + WS_FEAT); const bf16* W2T = (const bf16*)(ws + WS_W2T);
    bf16 *SR = (bf16*)(ws + WS_SR), *SK = (bf16*)(ws + WS_SK), *SV = (bf16*)(ws + WS_SV), *GG = (bf16*)(ws + WS_GG);
    bf16 *WF = (bf16*)((unsigned char*)a.out + DO_WF), *AF = (bf16*)((unsigned char*)a.out + DO_AF), *WB = (bf16*)((unsigned char*)a.out + DO_WB), *AB = (bf16*)((unsigned char*)a.out + DO_AB);
    const float *mup = a.in[I_MUP], *mun = a.in[I_MUN];
    unsigned long long pt0 = 0, pt1 = 0, pt2 = 0, ptl = 0;
    for (int tile = blockIdx.x; tile < MTOK / PT; tile += G) {
        const int m0 = tile * PT;
        if (PROBE_TA != 0) ptl = __builtin_amdgcn_s_memrealtime();
        const bool has_prev = (m0 & (SEQ - 1)) != 0, has_next = ((m0 + PT) & (SEQ - 1)) != 0;
        v4u stg[7];
#define PREP_STG_LOAD(C0) do { _Pragma("unroll") for (int q = 0; q < 7; ++q) { const int idx = lane + 64 * q; stg[q] = (v4u){0u, 0u, 0u, 0u}; if (idx < 408) { const int arr = idx / 136, rem = idx - arr * 136, row = rem >> 2, p = rem & 3; \
                    const bool ok = !((row == 0 && !has_prev) || (row == 33 && !has_next)); if (ok) stg[q] = *(const v4u*)(FT + (size_t)(m0 - 1 + row) * FEATP + arr * 1024 + (C0) + p * 8); } } } while (0)
        PREP_STG_LOAD(wave * 128);
        { LAS bf16* fst = (LAS bf16*)(lds + PT * ACTP * 2);
          const bool hp_ = (m0 & (SEQ - 1)) != 0, hn_ = ((m0 + PT) & (SEQ - 1)) != 0;
          for (int idx = tid; idx < 34 * 52; idx += NTHR) { const int row = idx / 52, p = idx - row * 52; const bool ok = !((row == 0 && !hp_) || (row == 33 && !hn_));
              v4u v = (v4u){0u, 0u, 0u, 0u}; if (ok) v = *(const v4u*)(FT + (size_t)(m0 - 1 + row) * FEATP + 3072 + p * 8);
              *(LAS v4u*)(fst + row * ACTP + p * 8) = v; }
          __syncthreads();
          if (tid < LORA_K) { const int j = tid; const float mp = mup[3072 + j], mn = mun[3072 + j]; float fp = bf2f(fst[j]), fc = bf2f(fst[ACTP + j]);
#pragma unroll 8
              for (int t = 0; t < PT; ++t) { const float fn = bf2f(fst[(t + 2) * ACTP + j]); float xs = shift_mix(fp, fc, fn, mp, mn);
                  if (j < 128) xs = 1.0f - 2.0f * __builtin_amdgcn_rcpf(1.0f + __builtin_amdgcn_exp2f(2.88539008178f * xs)); else if (j >= 256) xs = sigmoidf_(xs);
                  act[t * ACTP + j] = (bf16)f2bf(xs); fp = fc; fc = fn; } } }
        __syncthreads();
#pragma unroll 1
        for (int ct = 0; ct < 4; ++ct) { const int c0 = wave * 128 + ct * 32, c = c0 + r31;
            const float w0f = a.in[I_W0F][c], w0b = a.in[I_W0B][c], a0f = a.in[I_A0F][c], a0b = a.in[I_A0B][c];
            const float mpr = mup[c], mnr = mun[c], mpk = mup[1024 + c], mnk = mun[1024 + c], mpv = mup[2048 + c], mnv = mun[2048 + c];
            const bf16* brow = W2T + ((size_t)(c0 >> 5) * 26 * 64 + lane) * 8; const LAS bf16* arow = act + r31 * ACTP + 8 * hh;
            bf16x8_t bq[13];
#pragma unroll
            for (int u = 0; u < 13; ++u) bq[u] = *(const bf16x8_t*)(brow + u * 512);
            asm volatile("" ::: "memory");
            f32x16 cwf, cwb, caf, cab, cg;
#pragma unroll
            for (int e = 0; e < 16; ++e) { cwf[e] = 0.f; cwb[e] = 0.f; caf[e] = 0.f; cab[e] = 0.f; cg[e] = 0.f; }
#pragma unroll
            for (int half = 0; half < 2; ++half) {
                if (half == 1) {
#pragma unroll
                    for (int u = 0; u < 13; ++u) bq[u] = *(const bf16x8_t*)(brow + (13 + u) * 512); }
#pragma unroll
                for (int u = 0; u < 13; ++u) { const int kk = 13 * half + u; const bf16x8_t af_ = *(const LAS bf16x8_t*)(arow + 16 * kk); const bf16x8_t bf_ = bq[u];
                    if (kk < 4) cwf = __builtin_amdgcn_mfma_f32_32x32x16_bf16(af_, bf_, cwf, 0, 0, 0);
                    else if (kk < 8) cwb = __builtin_amdgcn_mfma_f32_32x32x16_bf16(af_, bf_, cwb, 0, 0, 0);
                    else if (kk < 12) caf = __builtin_amdgcn_mfma_f32_32x32x16_bf16(af_, bf_, caf, 0, 0, 0);
                    else if (kk < 16) cab = __builtin_amdgcn_mfma_f32_32x32x16_bf16(af_, bf_, cab, 0, 0, 0);
                    else cg = __builtin_amdgcn_mfma_f32_32x32x16_bf16(af_, bf_, cg, 0, 0, 0); } }
#pragma unroll
            for (int q = 0; q < 7; ++q) { const int idx = lane + 64 * q; if (idx < 408) { const int arr = idx / 136, rem = idx - arr * 136, row = rem >> 2, p = rem & 3; *(LAS v4u*)(inb + (arr * 34 + row) * PRP + p * 8) = stg[q]; } }
            PREP_STG_LOAD(wave * 128 + (ct < 3 ? ct + 1 : 3) * 32);
            if (PROBE_TA != 0) { asm volatile("s_waitcnt vmcnt(0) lgkmcnt(0)" ::: "memory"); const unsigned long long n_ = __builtin_amdgcn_s_memrealtime(); pt1 += n_ - ptl; ptl = n_; }
            asm volatile("s_waitcnt lgkmcnt(0)" ::: "memory");
#pragma unroll
            for (int gq = 0; gq < 4; ++gq) { const int t0 = 8 * gq + 4 * hh; float fr[6], fk[6], fv[6];
#pragma unroll
                for (int u = 0; u < 6; ++u) { const int row = t0 + u; fr[u] = bf2f(inb[row * PRP + r31]); fk[u] = bf2f(inb[(34 + row) * PRP + r31]); fv[u] = bf2f(inb[(68 + row) * PRP + r31]); }
                float o8[8][4];
#pragma unroll
                for (int u = 0; u < 4; ++u) { const int e = 4 * gq + u;
                    const float xr = shift_mix(fr[u], fr[u + 1], fr[u + 2], mpr, mnr), xk = shift_mix(fk[u], fk[u + 1], fk[u + 2], mpk, mnk), xv = shift_mix(fv[u], fv[u + 1], fv[u + 2], mpv, mnv);
                    const float ef = 0.60653066f * sigmoidf_(w0f + cwf[e]), eb = 0.60653066f * sigmoidf_(w0b + cwb[e]);
                    const float omwf = 1.0f - __builtin_amdgcn_exp2f(-1.44269504089f * ef), omwb = 1.0f - __builtin_amdgcn_exp2f(-1.44269504089f * eb);
                    const float af = sigmoidf_(a0f + caf[e]), ab = sigmoidf_(a0b + cab[e]);
                    o8[0][u] = xr; o8[1][u] = xk; o8[2][u] = xv; o8[3][u] = omwf; o8[4][u] = af; o8[5][u] = omwb; o8[6][u] = ab; o8[7][u] = cg[e]; }
                const unsigned ooff = bl_off(m0 >> 12, c0 >> 6, ((m0 & (SEQ - 1)) >> 3) + gq, (c0 & 63) + r31) + 4 * hh;
#pragma unroll
                for (int j = 0; j < 8; ++j) { bf16* dst = j == 0 ? SR : j == 1 ? SK : j == 2 ? SV : j == 3 ? WF : j == 4 ? AF : j == 5 ? WB : j == 6 ? AB : GG;
                    v2u w; w.x = pk2(o8[j][0], o8[j][1]); w.y = pk2(o8[j][2], o8[j][3]); *(v2u*)(dst + ooff) = w; } }
            if (PROBE_TA != 0) { const unsigned long long n_ = __builtin_amdgcn_s_memrealtime(); pt2 += n_ - ptl; ptl = n_; }
        }
        __syncthreads();
    }
    if (PROBE_TA != 0 && blockIdx.x == 0 && tid == 0) { unsigned long long* st = (unsigned long long*)(a.ws + WS_CTL + 32768); st[24] = pt0; st[25] = pt1; st[26] = pt2; st[27] = 0; }
}

constexpr int CL = 64, IP = 72, IMG_BYTES = 64 * IP * 2;
enum { SL_KH = 0, SL_KT = 1, SL_BT = 2, SL_RH = 3, SL_KHT = 4, SL_KBT = 5, SL_BBT = 6, SL_VT = 7, SL_A1T = 8, SL_A2T = 9, SL_A3 = 10, SL_A4 = 11, SL_DG = 12, SL_DGT = 13, SL_T = 14,
       SL_M = 0, SL_MT = 1, SL_M2 = 2, SL_Q = 8, SL_U = 12, SL_KQT = 13, SL_VNT = 0 };
constexpr int S1_MISC = 15 * IMG_BYTES;
__device__ __forceinline__ void mm_tile(f32x16& acc, const LAS bf16* A, int am0, const LAS bf16* B, int bn0, int r31, int hh) {
#pragma unroll
    for (int ks = 0; ks < 4; ++ks) { const bf16x8_t af = *(const LAS bf16x8_t*)(A + (am0 + r31) * IP + 16 * ks + 8 * hh); const bf16x8_t bq = *(const LAS bf16x8_t*)(B + (bn0 + r31) * IP + 16 * ks + 8 * hh);
        acc = __builtin_amdgcn_mfma_f32_32x32x16_bf16(af, bq, acc, 0, 0, 0); }
}
__device__ __forceinline__ void st_tileT(LAS bf16* img, const f32x16& acc, int m0, int n0, int r31, int hh) {
#pragma unroll
    for (int g = 0; g < 4; ++g) { v2u o; o.x = pk2(acc[4 * g], acc[4 * g + 1]); o.y = pk2(acc[4 * g + 2], acc[4 * g + 3]); *(LAS v2u*)(img + (n0 + r31) * IP + m0 + 8 * g + 4 * hh) = o; }
}
__device__ __forceinline__ void st_tileN(LAS bf16* img, const f32x16& acc, int m0, int n0, int r31, int hh) {
#pragma unroll
    for (int e = 0; e < 16; ++e) img[(m0 + crow(e, hh)) * IP + n0 + r31] = (bf16)f2bf(acc[e]);
}
__device__ __forceinline__ void st_tileT_perm(bf16* g, const f32x16& acc, int m0, int n0, int r31, int hh) {
#pragma unroll
    for (int p = 0; p < 2; ++p) { v4u o; o.x = pk2(acc[8 * p], acc[8 * p + 1]); o.y = pk2(acc[8 * p + 2], acc[8 * p + 3]); o.z = pk2(acc[8 * p + 4], acc[8 * p + 5]); o.w = pk2(acc[8 * p + 6], acc[8 * p + 7]);
        *(v4u*)(g + (size_t)(n0 + r31) * 64 + m0 + 16 * p + 8 * hh) = o; }
}
__device__ __forceinline__ void st_dump(bf16* g, const f32x16& acc, int mi, int ni, int lane) {
    v4u o0, o1; o0.x = pk2(acc[0], acc[1]); o0.y = pk2(acc[2], acc[3]); o0.z = pk2(acc[4], acc[5]); o0.w = pk2(acc[6], acc[7]);
    o1.x = pk2(acc[8], acc[9]); o1.y = pk2(acc[10], acc[11]); o1.z = pk2(acc[12], acc[13]); o1.w = pk2(acc[14], acc[15]);
    v4u* p = (v4u*)(g + ((size_t)(mi * 2 + ni) * 64 + lane) * 16); p[0] = o0; p[1] = o1;
}
__device__ __forceinline__ void zero16(f32x16& a) {
#pragma unroll
    for (int e = 0; e < 16; ++e) a[e] = 0.f;
}

__device__ __forceinline__ void phase_chunk_prep(const Args& a, LAS unsigned char* lds, int G) {
    const int tid = threadIdx.x, lane = tid & 63, wave = __builtin_amdgcn_readfirstlane(tid >> 6), r31 = lane & 31, hh = lane >> 5;
    unsigned char* ws = a.ws;
    const bf16 *SR = (const bf16*)(ws + WS_SR), *SK = (const bf16*)(ws + WS_SK), *SV = (const bf16*)(ws + WS_SV), *SKK = (const bf16*)(ws + WS_SKK);
    bf16 *CP = (bf16*)(ws + WS_CP), *CD = (bf16*)(ws + WS_CD), *CRQ = (bf16*)(ws + WS_CRQ), *COI = (bf16*)(ws + WS_COI);
#define SLOT(i) ((LAS bf16*)(lds + (i) * IMG_BYTES))
    LAS float* tot = (LAS float*)(lds + S1_MISC);
    LAS float* glv = tot + 512;
    const int mi = (wave >> 1) & 1, ni = wave & 1;
    unsigned long long tacc0 = 0, tacc1 = 0, tacc2 = 0, tacc3 = 0, tlast = 0;
#define S1T(ACC) do { if (PROBE_TA != 0) { const unsigned long long now_ = __builtin_amdgcn_s_memrealtime(); ACC += now_ - tlast; tlast = now_; } } while (0)
    v4u rawv[5];
    float kac_n = 0.f, kkc_n = 0.f;
#define S1_LOAD(IT) do { const int sid_ = (IT) >> 6, cs_ = (IT) & 63, dir_ = sid_ & 1, h_ = (sid_ >> 1) & 15, b_ = sid_ >> 5; const int tbase_ = dir_ ? (SEQ - CL * (cs_ + 1)) : CL * cs_; \
        const bf16* OMW_ = (const bf16*)((unsigned char*)a.out + (dir_ ? DO_WB : DO_WF)); const bf16* AA_ = (const bf16*)((unsigned char*)a.out + (dir_ ? DO_AB : DO_AF)); \
        const unsigned o = bl_off(b_, h_, (tbase_ >> 3) + (dir_ ? 7 - wave : wave), lane); \
        rawv[0] = *(const v4u*)(SR + o); rawv[1] = *(const v4u*)(SK + o); rawv[2] = *(const v4u*)(SV + o); rawv[3] = *(const v4u*)(OMW_ + o); rawv[4] = *(const v4u*)(AA_ + o); \
        kac_n = a.in[I_KA][h_ * 64 + lane]; kkc_n = a.in[I_KK][h_ * 64 + lane]; } while (0)
    if ((int)blockIdx.x < 4096) S1_LOAD(blockIdx.x);
    for (int item = blockIdx.x; item < 4096; item += G) {
        const int sid = item >> 6, h = (sid >> 1) & 15, dir = sid & 1;
        if (dir) {
#pragma unroll
            for (int q = 0; q < 5; ++q) { const v4u t_ = rawv[q]; rawv[q] = (v4u){__builtin_rotateleft32(t_.w, 16), __builtin_rotateleft32(t_.z, 16), __builtin_rotateleft32(t_.y, 16), __builtin_rotateleft32(t_.x, 16)}; } }
        unsigned short raw[6][8];
#pragma unroll
        for (int q = 0; q < 5; ++q) { const int qa = q < 3 ? q : q + 1;
#pragma unroll
            for (int i = 0; i < 8; ++i) { const unsigned w_ = rawv[q][i >> 1]; raw[qa][i] = (unsigned short)((i & 1) ? (w_ >> 16) : (w_ & 0xffffu)); } }
        if (PROBE_TA != 0) tlast = __builtin_amdgcn_s_memrealtime();
        { const int k = lane, tb = wave; const float kac = kac_n;
          float fr[8], fkd[8], fv[8], fkk[8], fb[8], e2[8];
          const float kkc = kkc_n;
          float k2v[8], ssq[8];
#pragma unroll
          for (int i = 0; i < 8; ++i) { k2v[i] = bf2f(raw[1][i]) * kkc; ssq[i] = wave_sum(k2v[i] * k2v[i]); }
#pragma unroll
          for (int i = 0; i < 8; ++i) { const float r_ = bf2f(raw[0][i]), k_ = bf2f(raw[1][i]), v_ = bf2f(raw[2][i]), kk_ = k2v[i] * (1.0f / sqrtf(fmaxf(ssq[i], 1e-24f))), om = bf2f(raw[4][i]), a_ = bf2f(raw[5][i]);
              fr[i] = r_; fv[i] = v_; fkk[i] = kk_; fkd[i] = k_ * (1.0f + (a_ - 1.0f) * kac); fb[i] = kk_ * a_; e2[i] = 1.0f - om; }
          float g[8]; g[0] = e2[0];
#pragma unroll
          for (int i = 1; i < 8; ++i) g[i] = g[i - 1] * e2[i];
          tot[tb * 64 + k] = -__builtin_amdgcn_logf(g[7]);
          for (int i = tid; i < 2 * IMG_BYTES / 16; i += NTHR) ((LAS v4u*)SLOT(SL_DG))[i] = (v4u){0u, 0u, 0u, 0u};
          __syncthreads(); S1T(tacc0);
          float pre = 0.f, gl = 0.f;
#pragma unroll
          for (int q = 0; q < 8; ++q) { const float tq = tot[q * 64 + k]; gl += tq; if (q < tb) pre += tq; }
          const float xm0 = __builtin_amdgcn_exp2f(-pre), glx = __builtin_amdgcn_exp2f(-gl);
          if (tb == 0) glv[k] = glx;
          float pkht[8], pkbt[8], pbbt[8];
#pragma unroll
          for (int i = 0; i < 8; ++i) { const int t = 8 * tb + i;
              const float xg = xm0 * g[i], xm = i == 0 ? xm0 : xm0 * g[i - 1], xp = __builtin_amdgcn_rcpf(xg), xl = glx * xp;
              const float kh = fkk[i] * xm, rh = fr[i] * xg, kt = fkd[i] * xp, bt = fb[i] * xp, kb = fkd[i] * xl, bb = -fb[i] * xl;
              SLOT(SL_KH)[t * IP + k] = (bf16)f2bf(kh); SLOT(SL_RH)[t * IP + k] = (bf16)f2bf(rh); SLOT(SL_KT)[t * IP + k] = (bf16)f2bf(kt); SLOT(SL_BT)[t * IP + k] = (bf16)f2bf(bt);
              pkht[i] = kh; pkbt[i] = kb; pbbt[i] = bb; }
          v4u w;
          w.x = pk2(pkht[0], pkht[1]); w.y = pk2(pkht[2], pkht[3]); w.z = pk2(pkht[4], pkht[5]); w.w = pk2(pkht[6], pkht[7]); *(LAS v4u*)(SLOT(SL_KHT) + k * IP + 8 * tb) = w;
          w.x = pk2(pkbt[0], pkbt[1]); w.y = pk2(pkbt[2], pkbt[3]); w.z = pk2(pkbt[4], pkbt[5]); w.w = pk2(pkbt[6], pkbt[7]); *(LAS v4u*)(SLOT(SL_KBT) + k * IP + 8 * tb) = w;
          w.x = pk2(pbbt[0], pbbt[1]); w.y = pk2(pbbt[2], pbbt[3]); w.z = pk2(pbbt[4], pbbt[5]); w.w = pk2(pbbt[6], pbbt[7]); *(LAS v4u*)(SLOT(SL_BBT) + k * IP + 8 * tb) = w;
          w.x = (unsigned)raw[2][0] | ((unsigned)raw[2][1] << 16); w.y = (unsigned)raw[2][2] | ((unsigned)raw[2][3] << 16); w.z = (unsigned)raw[2][4] | ((unsigned)raw[2][5] << 16); w.w = (unsigned)raw[2][6] | ((unsigned)raw[2][7] << 16); *(LAS v4u*)(SLOT(SL_VT) + k * IP + 8 * tb) = w;
        }
        __syncthreads(); S1T(tacc1);
        if (item + G < 4096) S1_LOAD(item + G);
        { const int prod = wave >> 2; f32x16 acc; zero16(acc); mm_tile(acc, SLOT(SL_KH), 32 * mi, prod ? SLOT(SL_KT) : SLOT(SL_BT), 32 * ni, r31, hh);
          const int n = 32 * ni + r31;
#pragma unroll
          for (int e = 0; e < 16; ++e) { const int m = 32 * mi + crow(e, hh); if (!(n < m)) acc[e] = 0.f; }
          st_tileT(SLOT(SL_A1T + prod), acc, 32 * mi, 32 * ni, r31, hh); }
        __syncthreads(); S1T(tacc2);
        if (wave == 0) { const int bi = lane >> 4, c = lane & 15; float X[16];
#pragma unroll
            for (int t = 0; t < 16; ++t) X[t] = (t == c) ? 1.f : 0.f;
#pragma unroll
            for (int s = 0; s < 15; ++s) { const LAS bf16* rowp = SLOT(SL_A1T) + (16 * bi + s) * IP + 16 * bi;
                const v4u q0 = *(const LAS v4u*)rowp, q1 = *(const LAS v4u*)(rowp + 8); const float xs = X[s];
#pragma unroll
                for (int t = s + 1; t < 16; ++t) { const unsigned wv = t < 8 ? q0[t >> 1] : q1[(t - 8) >> 1]; const float nv = (t & 1) ? bfhi(wv) : bflo(wv); X[t] -= nv * xs; } }
#pragma unroll
            for (int t = 0; t < 16; ++t) SLOT(SL_DG)[(16 * bi + t) * IP + 16 * bi + c] = (bf16)f2bf(X[t]);
            v4u w0, w1; w0.x = pk2(X[0], X[1]); w0.y = pk2(X[2], X[3]); w0.z = pk2(X[4], X[5]); w0.w = pk2(X[6], X[7]); w1.x = pk2(X[8], X[9]); w1.y = pk2(X[10], X[11]); w1.z = pk2(X[12], X[13]); w1.w = pk2(X[14], X[15]);
            LAS v4u* dp = (LAS v4u*)(SLOT(SL_DGT) + (16 * bi + c) * IP + 16 * bi); dp[0] = w0; dp[1] = w1; }
        else {
#pragma unroll 1
            for (int tl = wave - 1; tl < 8; tl += 7) { const int prod = tl >> 2, gm = (tl >> 1) & 1, gn = tl & 1;
                f32x16 acc; zero16(acc); mm_tile(acc, prod ? SLOT(SL_KT) : SLOT(SL_BT), 32 * gm, SLOT(SL_RH), 32 * gn, r31, hh);
                const int n = 32 * gn + r31;
#pragma unroll
                for (int e = 0; e < 16; ++e) { const int m = 32 * gm + crow(e, hh); acc[e] = (m <= n) ? (prod ? acc[e] : -acc[e]) : 0.f; }
                st_tileT(SLOT(SL_A3 + prod), acc, 32 * gm, 32 * gn, r31, hh); } }
        __syncthreads(); S1T(tacc3);
        f32x16 c2;
        if (wave < 4) { f32x16 acc; zero16(acc); mm_tile(acc, SLOT(SL_A1T), 32 * mi, SLOT(SL_DG), 32 * ni, r31, hh);
            const int n = 32 * ni + r31;
#pragma unroll
            for (int e = 0; e < 16; ++e) { const int m = 32 * mi + crow(e, hh); if ((m >> 4) == (n >> 4)) acc[e] = 0.f; }
            st_tileT(SLOT(SL_M), acc, 32 * mi, 32 * ni, r31, hh); st_tileN(SLOT(SL_MT), acc, 32 * mi, 32 * ni, r31, hh); }
        __syncthreads();
        if (wave < 4) { zero16(c2); mm_tile(c2, SLOT(SL_MT), 32 * mi, SLOT(SL_M), 32 * ni, r31, hh); st_tileT(SLOT(SL_M2), c2, 32 * mi, 32 * ni, r31, hh); }
        __syncthreads();
        if (wave < 4) { f32x16 c3; zero16(c3); mm_tile(c3, SLOT(SL_MT), 32 * mi, SLOT(SL_M2), 32 * ni, r31, hh);
            const int n = 32 * ni + r31;
#pragma unroll
            for (int g = 0; g < 4; ++g) { const v2u mw = *(const LAS v2u*)(SLOT(SL_M) + n * IP + 32 * mi + 8 * g + 4 * hh);
#pragma unroll
                for (int i = 0; i < 4; ++i) { const int e = 4 * g + i; const int m = 32 * mi + crow(e, hh); const unsigned wv = mw[i >> 1]; const float mt = (i & 1) ? bfhi(wv) : bflo(wv);
                    c3[e] = ((m == n) ? 1.f : 0.f) - mt + c2[e] - c3[e]; } }
            st_tileT(SLOT(SL_Q), c3, 32 * mi, 32 * ni, r31, hh); }
        __syncthreads();
        if (wave < 4) { f32x16 acc; zero16(acc); mm_tile(acc, SLOT(SL_DGT), 32 * mi, SLOT(SL_Q), 32 * ni, r31, hh); st_tileT(SLOT(SL_T), acc, 32 * mi, 32 * ni, r31, hh); }
        __syncthreads(); S1T(tacc3);
        { f32x16 acc; zero16(acc);
          if (wave < 4) { mm_tile(acc, SLOT(SL_T), 32 * mi, SLOT(SL_KHT), 32 * ni, r31, hh); st_tileT(SLOT(SL_KQT), acc, 32 * mi, 32 * ni, r31, hh); }
          else { mm_tile(acc, SLOT(SL_A2T), 32 * mi, SLOT(SL_T), 32 * ni, r31, hh); st_tileT(SLOT(SL_U), acc, 32 * mi, 32 * ni, r31, hh); } }
        __syncthreads();
        { f32x16 acc; zero16(acc);
          if (wave < 4) { mm_tile(acc, SLOT(SL_U), 32 * mi, SLOT(SL_VT), 32 * ni, r31, hh); st_tileT(SLOT(SL_VNT), acc, 32 * mi, 32 * ni, r31, hh); }
          else { const int n = 32 * ni + r31;
              mm_tile(acc, SLOT(SL_KQT), 32 * mi, SLOT(SL_BBT), 32 * ni, r31, hh);
              const float gln = glv[n];
#pragma unroll
              for (int e = 0; e < 16; ++e) { const int m = 32 * mi + crow(e, hh); if (m == n) acc[e] += gln; }
              st_tileT_perm(CP + (size_t)item * 4096, acc, 32 * mi, 32 * ni, r31, hh);
              zero16(acc); mm_tile(acc, SLOT(SL_KQT), 32 * mi, SLOT(SL_A3), 32 * ni, r31, hh);
#pragma unroll
              for (int g = 0; g < 4; ++g) { const v2u rw = *(const LAS v2u*)(SLOT(SL_RH) + n * IP + 32 * mi + 8 * g + 4 * hh);
                  acc[4 * g] += bflo(rw.x); acc[4 * g + 1] += bfhi(rw.x); acc[4 * g + 2] += bflo(rw.y); acc[4 * g + 3] += bfhi(rw.y); }
              st_tileT_perm(CRQ + (size_t)item * 4096, acc, 32 * mi, 32 * ni, r31, hh); } }
        __syncthreads();
        { f32x16 acc; zero16(acc);
          if (wave < 4) { mm_tile(acc, SLOT(SL_A4), 32 * mi, SLOT(SL_VT), 32 * ni, r31, hh); mm_tile(acc, SLOT(SL_A3), 32 * mi, SLOT(SL_VNT), 32 * ni, r31, hh); st_dump(COI + (size_t)item * 4096, acc, mi, ni, lane); }
          else { mm_tile(acc, SLOT(SL_KBT), 32 * mi, SLOT(SL_VT), 32 * ni, r31, hh); mm_tile(acc, SLOT(SL_BBT), 32 * mi, SLOT(SL_VNT), 32 * ni, r31, hh); st_dump(CD + (size_t)item * 4096, acc, mi, ni, lane); } }
        __syncthreads(); S1T(tacc3);
    }
#undef SLOT
    if (PROBE_TA != 0 && blockIdx.x == 0 && tid == 0) { unsigned long long* st = (unsigned long long*)(a.ws + WS_CTL + 32768); st[20] = tacc0; st[21] = tacc1; st[22] = tacc2; st[23] = tacc3; }
}

constexpr int S2I_SLOT = 4096;
constexpr int S2I_GRP = 8 * S2I_SLOT * 2;
constexpr int S2I_MISC = 2 * S2I_GRP;
__device__ __forceinline__ int swz(int row, int col) { return row * 64 + ((((col) >> 3) ^ (((row) >> 1) & 7)) << 3) + ((col) & 7); }
__device__ __forceinline__ void mm_tileS(f32x16& acc, const LAS bf16* A, int am0, const LAS bf16* B, int bn0, int r31, int hh) {
    const int ra = am0 + r31, rb = bn0 + r31, sa = (ra >> 1) & 7, sb = (rb >> 1) & 7;
#pragma unroll
    for (int ks = 0; ks < 4; ++ks) { const int ch = 2 * ks + hh;
        const bf16x8_t af = *(const LAS bf16x8_t*)(A + ra * 64 + ((ch ^ sa) << 3)); const bf16x8_t bq = *(const LAS bf16x8_t*)(B + rb * 64 + ((ch ^ sb) << 3));
        acc = __builtin_amdgcn_mfma_f32_32x32x16_bf16(af, bq, acc, 0, 0, 0); }
}
__device__ __forceinline__ void st_tileTS(LAS bf16* img, const f32x16& acc, int m0, int n0, int r31, int hh) {
    const int row = n0 + r31, s = (row >> 1) & 7;
#pragma unroll
    for (int g = 0; g < 4; ++g) { v2u o; o.x = pk2(acc[4 * g], acc[4 * g + 1]); o.y = pk2(acc[4 * g + 2], acc[4 * g + 3]);
        *(LAS v2u*)(img + row * 64 + ((((m0 >> 3) + g) ^ s) << 3) + 4 * hh) = o; }
}
__device__ __forceinline__ void st_tileNS(LAS bf16* img, const f32x16& acc, int m0, int n0, int r31, int hh) {
#pragma unroll
    for (int e = 0; e < 16; ++e) img[swz(m0 + crow(e, hh), n0 + r31)] = (bf16)f2bf(acc[e]);
}
__device__ __forceinline__ v2u rd4S(const LAS bf16* img, int row, int col4) { return *(const LAS v2u*)(img + row * 64 + ((((col4) >> 3) ^ ((row >> 1) & 7)) << 3) + (col4 & 7)); }
__device__ __forceinline__ float bfel(const v4u& v, int i) { const unsigned w = v[i >> 1]; return (i & 1) ? bfhi(w) : bflo(w); }

__device__ __forceinline__ void phase_chunk_prep2(const Args& a, LAS unsigned char* lds, int G) {
    const int tid = threadIdx.x, lane0 = tid & 63, wave = __builtin_amdgcn_readfirstlane(tid >> 6);
    const int grp = wave >> 2, wq = wave & 3, mi = wq >> 1, ni = wq & 1;
    unsigned char* ws = a.ws;
    const bf16 *SR = (const bf16*)(ws + WS_SR), *SK = (const bf16*)(ws + WS_SK), *SV = (const bf16*)(ws + WS_SV);
    const bf16 *WFp = (const bf16*)((unsigned char*)a.out + DO_WF), *AFp = (const bf16*)((unsigned char*)a.out + DO_AF), *WBp = (const bf16*)((unsigned char*)a.out + DO_WB), *ABp = (const bf16*)((unsigned char*)a.out + DO_AB);
    bf16 *CP = (bf16*)(ws + WS_CP), *CD = (bf16*)(ws + WS_CD), *CRQ = (bf16*)(ws + WS_CRQ), *COI = (bf16*)(ws + WS_COI);
#define XS(g, i) ((LAS bf16*)(lds + (g) * S2I_GRP) + (i) * S2I_SLOT)
#define GS(i) XS(grp, i)
    LAS float* tot = (LAS float*)(lds + S2I_MISC);
    LAS float* glv = tot + 1024;
    v4u rawv[7]; float kac_n = 0.f, kkc_n = 0.f;
    unsigned long long q0_ = 0, q1_ = 0, q2_ = 0, q3_ = 0, ql_ = 0;
#define S2T(ACC) do { if (PROBE_TA != 0) { const unsigned long long n_ = __builtin_amdgcn_s_memrealtime(); ACC += n_ - ql_; ql_ = n_; } } while (0)
#define S1B_LOAD(P) do { const int ct_ = (P) & 63, h_ = ((P) >> 6) & 15, b_ = (P) >> 10; const unsigned o = bl_off(b_, h_, 8 * ct_ + wave, lane0); \
        rawv[0] = *(const v4u*)(SR + o); rawv[1] = *(const v4u*)(SK + o); rawv[2] = *(const v4u*)(SV + o); rawv[3] = *(const v4u*)(WFp + o); rawv[4] = *(const v4u*)(AFp + o); \
        rawv[5] = *(const v4u*)(WBp + o); rawv[6] = *(const v4u*)(ABp + o); kac_n = a.in[I_KA][h_ * 64 + lane0]; kkc_n = a.in[I_KK][h_ * 64 + lane0]; } while (0)
    S1B_LOAD(blockIdx.x);
    for (int pair = blockIdx.x; pair < 2048; pair += G) {
        const int ct = pair & 63, h = (pair >> 6) & 15, b = pair >> 10;
        int lane = lane0; asm volatile("" : "+v"(lane));
        const int r31 = lane & 31, hh = lane >> 5;
        int offA[4], offB[4], offT[4];
        { const int rA = 32 * mi + r31, rB = 32 * ni + r31, sA = (rA >> 1) & 7, sB = (rB >> 1) & 7;
#pragma unroll
          for (int q = 0; q < 4; ++q) { offA[q] = rA * 64 + (((2 * q + hh) ^ sA) << 3); offB[q] = rB * 64 + (((2 * q + hh) ^ sB) << 3); offT[q] = rB * 64 + (((4 * mi + q) ^ sB) << 3) + 4 * hh; } }
#define MMT(ACC, AIMG, BIMG) do { _Pragma("unroll") for (int ks_ = 0; ks_ < 4; ++ks_) ACC = __builtin_amdgcn_mfma_f32_32x32x16_bf16(*(const LAS bf16x8_t*)((AIMG) + offA[ks_]), *(const LAS bf16x8_t*)((BIMG) + offB[ks_]), ACC, 0, 0, 0); } while (0)
#define STT(IMG, ACC) do { _Pragma("unroll") for (int g_ = 0; g_ < 4; ++g_) { v2u o_; o_.x = pk2(ACC[4 * g_], ACC[4 * g_ + 1]); o_.y = pk2(ACC[4 * g_ + 2], ACC[4 * g_ + 3]); *(LAS v2u*)((IMG) + offT[g_]) = o_; } } while (0)
        if (PROBE_TA != 0) ql_ = __builtin_amdgcn_s_memrealtime();
        const int item = grp ? (((b * 16 + h) * 2 + 1) * 64 + (63 - ct)) : (((b * 16 + h) * 2) * 64 + ct);
        v4u khT[2], kbT[2], bbT[2], rhP[2], vT[2];
        { const int k = lane; const float kac = kac_n, kkc = kkc_n;
          float r[8], kr[8], kkv[8];
#pragma unroll
          for (int j = 0; j < 8; ++j) { r[j] = bfel(rawv[0], j); kr[j] = bfel(rawv[1], j); }
#pragma unroll
          for (int j = 0; j < 8; ++j) { const float k2 = kr[j] * kkc; const float ss = wave_sum(k2 * k2); kkv[j] = k2 * __builtin_amdgcn_rsqf(fmaxf(ss, 1e-24f)); }
          vT[0] = rawv[2];
          vT[1] = (v4u){__builtin_rotateleft32(rawv[2].w, 16), __builtin_rotateleft32(rawv[2].z, 16), __builtin_rotateleft32(rawv[2].y, 16), __builtin_rotateleft32(rawv[2].x, 16)};
#pragma unroll
          for (int d = 0; d < 2; ++d) { float pw = 1.0f;
#pragma unroll
              for (int j = 0; j < 8; ++j) pw *= 1.0f - bfel(rawv[3 + 2 * d], j);
              tot[(d * 8 + (d ? 7 - wave : wave)) * 64 + k] = -__builtin_amdgcn_logf(pw); }
          __syncthreads();
#pragma unroll
          for (int d = 0; d < 2; ++d) { const int sb = d ? 7 - wave : wave; float pre = 0.f, gl = 0.f;
#pragma unroll
              for (int q = 0; q < 8; ++q) { const float tq = tot[(d * 8 + q) * 64 + k]; gl += tq; if (q < sb) pre += tq; }
              const float xm0 = __builtin_amdgcn_exp2f(-pre), glx = __builtin_amdgcn_exp2f(-gl);
              if (sb == 0) glv[d * 64 + k] = glx;
              float khv[8], kbv[8], bbv[8], rhv[8]; float xm = xm0;
#pragma unroll
              for (int i = 0; i < 8; ++i) { const int j = d ? 7 - i : i; const int t = 8 * sb + i;
                  const float om = bfel(rawv[3 + 2 * d], j), a_ = bfel(rawv[4 + 2 * d], j);
                  const float kd_ = kr[j] * (1.0f + (a_ - 1.0f) * kac), fb_ = kkv[j] * a_;
                  const float xg = xm * (1.0f - om), xp = __builtin_amdgcn_rcpf(xg), xl = glx * xp;
                  const float kh = kkv[j] * xm, rh = r[j] * xg, kt = kd_ * xp, bt = fb_ * xp;
                  khv[i] = kh; rhv[i] = rh; kbv[i] = kd_ * xl; bbv[i] = -fb_ * xl; xm = xg;
                  const int o = swz(t, k);
                  XS(d, 0)[o] = (bf16)f2bf(kh); XS(d, 1)[o] = (bf16)f2bf(kt); XS(d, 2)[o] = (bf16)f2bf(bt); XS(d, 3)[o] = (bf16)f2bf(rh); }
              khT[d] = (v4u){pk2(khv[0], khv[1]), pk2(khv[2], khv[3]), pk2(khv[4], khv[5]), pk2(khv[6], khv[7])};
              kbT[d] = (v4u){pk2(kbv[0], kbv[1]), pk2(kbv[2], kbv[3]), pk2(kbv[4], kbv[5]), pk2(kbv[6], kbv[7])};
              bbT[d] = (v4u){pk2(bbv[0], bbv[1]), pk2(bbv[2], bbv[3]), pk2(bbv[4], bbv[5]), pk2(bbv[6], bbv[7])};
              rhP[d] = (v4u){pk2(rhv[0], rhv[1]), pk2(rhv[2], rhv[3]), pk2(rhv[4], rhv[5]), pk2(rhv[6], rhv[7])}; }
        }
        __syncthreads();
        if (pair + G < 2048) S1B_LOAD(pair + G);
#define JIT_T(SLOTI, REG) do { _Pragma("unroll") for (int d = 0; d < 2; ++d) { const int sb_ = d ? 7 - wave : wave; *(LAS v4u*)(XS(d, SLOTI) + lane * 64 + ((sb_ ^ ((lane >> 1) & 7)) << 3)) = REG[d]; } } while (0)
#pragma unroll
        for (int prod = 0; prod < 4; ++prod) { f32x16 acc; zero16(acc);
            MMT(acc, prod < 2 ? GS(0) : (prod == 2 ? GS(2) : GS(1)), prod == 0 ? GS(2) : (prod == 1 ? GS(1) : GS(3)));
            const int n = 32 * ni + r31;
#pragma unroll
            for (int e = 0; e < 16; ++e) { const int m = 32 * mi + crow(e, hh); const bool keep = prod < 2 ? (n < m) : (m <= n); acc[e] = keep ? (prod == 2 ? -acc[e] : acc[e]) : 0.f; }
            STT(GS(4 + prod), acc); }
        __syncthreads(); if (PROBE_TA != 0) ql_ = __builtin_amdgcn_s_memrealtime();
        float X[16];
        if (wq == 0) { const int bi = lane >> 4, c = lane & 15;
#pragma unroll
            for (int t = 0; t < 16; ++t) X[t] = (t == c) ? 1.f : 0.f;
#pragma unroll
            for (int s = 0; s < 15; ++s) { const int row = 16 * bi + s, sw_ = (row >> 1) & 7;
                const v4u q0 = *(const LAS v4u*)(GS(4) + row * 64 + (((2 * bi) ^ sw_) << 3)), q1 = *(const LAS v4u*)(GS(4) + row * 64 + (((2 * bi + 1) ^ sw_) << 3)); const float xs = X[s];
#pragma unroll
                for (int t = s + 1; t < 16; ++t) { const unsigned wv = t < 8 ? q0[t >> 1] : q1[(t - 8) >> 1]; const float nv = (t & 1) ? bfhi(wv) : bflo(wv); X[t] -= nv * xs; } } }
        else { for (int i = (wq - 1) * 64 + lane; i < 1024; i += 192) ((LAS v4u*)GS(0))[i] = (v4u){0u, 0u, 0u, 0u}; }
        __syncthreads();
        if (wq == 0) { const int bi = lane >> 4, c = lane & 15;
#pragma unroll
            for (int t = 0; t < 16; ++t) GS(0)[swz(16 * bi + t, 16 * bi + c)] = (bf16)f2bf(X[t]);
            const int row = 16 * bi + c, sw_ = (row >> 1) & 7;
            *(LAS v4u*)(GS(1) + row * 64 + (((2 * bi) ^ sw_) << 3)) = (v4u){pk2(X[0], X[1]), pk2(X[2], X[3]), pk2(X[4], X[5]), pk2(X[6], X[7])};
            *(LAS v4u*)(GS(1) + row * 64 + (((2 * bi + 1) ^ sw_) << 3)) = (v4u){pk2(X[8], X[9]), pk2(X[10], X[11]), pk2(X[12], X[13]), pk2(X[14], X[15])}; }
        __syncthreads(); S2T(q0_);
        f32x16 c2;
        { f32x16 acc; zero16(acc); MMT(acc, GS(4), GS(0));
          const int n = 32 * ni + r31;
#pragma unroll
          for (int e = 0; e < 16; ++e) { const int m = 32 * mi + crow(e, hh); if ((m >> 4) == (n >> 4)) acc[e] = 0.f; }
          STT(GS(2), acc); st_tileNS(GS(3), acc, 32 * mi, 32 * ni, r31, hh); }
        __syncthreads();
        zero16(c2); MMT(c2, GS(3), GS(2)); STT(GS(4), c2);
        __syncthreads();
        { f32x16 c3; zero16(c3); MMT(c3, GS(3), GS(4));
          const int n = 32 * ni + r31;
#pragma unroll
          for (int g = 0; g < 4; ++g) { const v2u mw = *(const LAS v2u*)(GS(2) + offT[g]);
#pragma unroll
              for (int i = 0; i < 4; ++i) { const int e = 4 * g + i; const int m = 32 * mi + crow(e, hh); const unsigned wv = mw[i >> 1]; const float mt = (i & 1) ? bfhi(wv) : bflo(wv);
                  c3[e] = ((m == n) ? 1.f : 0.f) - mt + c2[e] - c3[e]; } }
          STT(GS(0), c3); }
        __syncthreads();
        { f32x16 acc; zero16(acc); MMT(acc, GS(1), GS(0)); STT(GS(2), acc); }
        JIT_T(3, khT);
        __syncthreads(); S2T(q1_);
        { f32x16 acc; zero16(acc); MMT(acc, GS(2), GS(3)); STT(GS(1), acc);
          zero16(acc); MMT(acc, GS(5), GS(2)); STT(GS(0), acc); }
        JIT_T(4, vT);
        __syncthreads();
        JIT_T(2, bbT);
#pragma unroll
        for (int d = 0; d < 2; ++d) { const int sb_ = d ? 7 - wave : wave;
#pragma unroll
            for (int i = 0; i < 8; ++i) { const unsigned w_ = rhP[d][i >> 1]; XS(d, 3)[swz(8 * sb_ + i, lane)] = (bf16)((i & 1) ? (w_ >> 16) : (w_ & 0xffffu)); } }
        __syncthreads(); S2T(q2_);
        { f32x16 acc; zero16(acc); MMT(acc, GS(0), GS(4)); STT(GS(5), acc);
          const int n = 32 * ni + r31;
          zero16(acc); MMT(acc, GS(1), GS(2));
          const float gln = glv[grp * 64 + n];
#pragma unroll
          for (int e = 0; e < 16; ++e) { const int m = 32 * mi + crow(e, hh); if (m == n) acc[e] += gln; }
          st_tileT_perm(CP + (size_t)item * 4096, acc, 32 * mi, 32 * ni, r31, hh);
          zero16(acc); MMT(acc, GS(1), GS(6));
#pragma unroll
          for (int g = 0; g < 4; ++g) { const v2u rw = *(const LAS v2u*)(GS(3) + offT[g]);
              acc[4 * g] += bflo(rw.x); acc[4 * g + 1] += bfhi(rw.x); acc[4 * g + 2] += bflo(rw.y); acc[4 * g + 3] += bfhi(rw.y); }
          st_tileT_perm(CRQ + (size_t)item * 4096, acc, 32 * mi, 32 * ni, r31, hh); }
        __syncthreads();
        JIT_T(0, kbT);
        __syncthreads();
        { f32x16 acc; zero16(acc); MMT(acc, GS(7), GS(4)); MMT(acc, GS(6), GS(5)); st_dump(COI + (size_t)item * 4096, acc, mi, ni, lane);
          zero16(acc); MMT(acc, GS(0), GS(4)); MMT(acc, GS(2), GS(5)); st_dump(CD + (size_t)item * 4096, acc, mi, ni, lane); }
        __syncthreads(); S2T(q3_);
    }
    if (PROBE_TA != 0 && blockIdx.x == 0 && tid == 0) { unsigned long long* st = (unsigned long long*)(a.ws + WS_CTL + 32768); st[20] = q0_; st[21] = q1_; st[22] = q2_; st[23] = q3_; }
#undef MMT
#undef STT
#undef XS
#undef GS
#undef JIT_T
#undef S1B_LOAD
}

constexpr int S2_BUF = 2 * IMG_BYTES + 2 * 8192;
template <int DIR> __device__ __forceinline__ void s2_compute(LAS unsigned char* lds, bf16* OO, int b, int h, int wave, int lane) {
    const int r31 = lane & 31, hh = lane >> 5;
            const int j = wave;
            f32x16 X0, X1; zero16(X0); zero16(X1);
            __syncthreads();
            for (int c = 0; c < 64; ++c) {
                const LAS unsigned char* bb = lds + (c & 1) * S2_BUF;
                const LAS bf16* Pim = (const LAS bf16*)bb; const LAS bf16* Rim = (const LAS bf16*)(bb + IMG_BYTES);
                f32x16 aS0, aS1, aO0, aO1;
                { const LAS v4u* dp = (const LAS v4u*)(bb + 2 * IMG_BYTES);
                  const v4u d00 = dp[((0 * 2 + j) * 64 + lane) * 2], d01 = dp[((0 * 2 + j) * 64 + lane) * 2 + 1], d10 = dp[((1 * 2 + j) * 64 + lane) * 2], d11 = dp[((1 * 2 + j) * 64 + lane) * 2 + 1];
                  const LAS v4u* op = (const LAS v4u*)(bb + 2 * IMG_BYTES + 8192);
                  const v4u o00 = op[((0 * 2 + j) * 64 + lane) * 2], o01 = op[((0 * 2 + j) * 64 + lane) * 2 + 1], o10 = op[((1 * 2 + j) * 64 + lane) * 2], o11 = op[((1 * 2 + j) * 64 + lane) * 2 + 1];
#pragma unroll
                  for (int q = 0; q < 4; ++q) { aS0[2 * q] = bflo(d00[q]); aS0[2 * q + 1] = bfhi(d00[q]); aS0[8 + 2 * q] = bflo(d01[q]); aS0[8 + 2 * q + 1] = bfhi(d01[q]);
                      aS1[2 * q] = bflo(d10[q]); aS1[2 * q + 1] = bfhi(d10[q]); aS1[8 + 2 * q] = bflo(d11[q]); aS1[8 + 2 * q + 1] = bfhi(d11[q]);
                      aO0[2 * q] = bflo(o00[q]); aO0[2 * q + 1] = bfhi(o00[q]); aO0[8 + 2 * q] = bflo(o01[q]); aO0[8 + 2 * q + 1] = bfhi(o01[q]);
                      aO1[2 * q] = bflo(o10[q]); aO1[2 * q + 1] = bfhi(o10[q]); aO1[8 + 2 * q] = bflo(o11[q]); aO1[8 + 2 * q + 1] = bfhi(o11[q]); } }
#pragma unroll
                for (int ks = 0; ks < 4; ++ks) {
                    v4u bh;
#pragma unroll
                    for (int q = 0; q < 4; ++q) { const int e = 8 * (ks & 1) + 2 * q; const float x0 = (ks < 2) ? X0[e] : X1[e], x1 = (ks < 2) ? X0[e + 1] : X1[e + 1]; bh[q] = pk2(x0, x1); }
                    const bf16x8_t Bh = __builtin_bit_cast(bf16x8_t, bh);
                    const bf16x8_t p0 = *(const LAS bf16x8_t*)(Pim + (r31) * IP + 16 * ks + 8 * hh), p1 = *(const LAS bf16x8_t*)(Pim + (32 + r31) * IP + 16 * ks + 8 * hh);
                    const bf16x8_t q0 = *(const LAS bf16x8_t*)(Rim + (r31) * IP + 16 * ks + 8 * hh), q1 = *(const LAS bf16x8_t*)(Rim + (32 + r31) * IP + 16 * ks + 8 * hh);
                    aS0 = __builtin_amdgcn_mfma_f32_32x32x16_bf16(p0, Bh, aS0, 0, 0, 0); aS1 = __builtin_amdgcn_mfma_f32_32x32x16_bf16(p1, Bh, aS1, 0, 0, 0);
                    aO0 = __builtin_amdgcn_mfma_f32_32x32x16_bf16(q0, Bh, aO0, 0, 0, 0); aO1 = __builtin_amdgcn_mfma_f32_32x32x16_bf16(q1, Bh, aO1, 0, 0, 0); }
                const int tblk0 = (DIR ? (SEQ - CL * (c + 1)) : CL * c) >> 3;
#pragma unroll
                for (int i2 = 0; i2 < 2; ++i2)
#pragma unroll
                    for (int g = 0; g < 4; ++g) { const float x0 = i2 ? aO1[4 * g] : aO0[4 * g], x1 = i2 ? aO1[4 * g + 1] : aO0[4 * g + 1], x2 = i2 ? aO1[4 * g + 2] : aO0[4 * g + 2], x3 = i2 ? aO1[4 * g + 3] : aO0[4 * g + 3];
                        v2u w; int tblk, toff;
                        if (DIR) { w.x = pk2(x3, x2); w.y = pk2(x1, x0); tblk = tblk0 + 7 - 4 * i2 - g; toff = 4 - 4 * hh; } else { w.x = pk2(x0, x1); w.y = pk2(x2, x3); tblk = tblk0 + 4 * i2 + g; toff = 4 * hh; }
                        *(v2u*)(OO + bl_off(b, h, tblk, 32 * j + r31) + toff) = w; }
                X0 = aS0; X1 = aS1;
                __syncthreads();
            }
        }
__device__ __forceinline__ void phase_chunk_scan(const Args& a, LAS unsigned char* lds, int G) {
    const int tid = threadIdx.x, lane = tid & 63, wave = __builtin_amdgcn_readfirstlane(tid >> 6), r31 = lane & 31, hh = lane >> 5;
    unsigned char* ws = a.ws;
    const bf16 *CP = (const bf16*)(ws + WS_CP), *CD = (const bf16*)(ws + WS_CD), *CRQ = (const bf16*)(ws + WS_CRQ), *COI = (const bf16*)(ws + WS_COI);
    for (int sid = blockIdx.x; sid < 64; sid += G) {
        const int dir = sid & 1, h = (sid >> 1) & 15, b = sid >> 5;
        bf16* OO = (bf16*)((unsigned char*)a.out + (dir ? DO_WB : DO_WF));
        if (wave >= 2) {
            const int lt = tid - 128;
            v4u rg[6];
#define S2_LOAD(c) do { const size_t ib = ((size_t)sid * 64 + (c)) * 4096; _Pragma("unroll") for (int q = 0; q < 6; ++q) { const int idx = lt + 384 * q; if (idx < 2048) { const int arr = idx >> 9, ch = idx & 511; \
                const bf16* src = arr == 0 ? CP : (arr == 1 ? CRQ : (arr == 2 ? CD : COI)); rg[q] = *(const v4u*)(src + ib + ch * 8); } } } while (0)
#define S2_WRITE(c) do { LAS unsigned char* bb = lds + ((c) & 1) * S2_BUF; _Pragma("unroll") for (int q = 0; q < 6; ++q) { const int idx = lt + 384 * q; if (idx < 2048) { const int arr = idx >> 9, ch = idx & 511; \
                LAS unsigned char* dst = arr < 2 ? (bb + arr * IMG_BYTES + (ch >> 3) * (IP * 2) + (ch & 7) * 16) : (bb + 2 * IMG_BYTES + (arr - 2) * 8192 + ch * 16); *(LAS v4u*)dst = rg[q]; } } } while (0)
            S2_LOAD(0); S2_WRITE(0); S2_LOAD(1);
            __syncthreads();
            for (int c = 0; c < 64; ++c) {
                if (c + 1 < 64) S2_WRITE(c + 1);
                if (c + 2 < 64) S2_LOAD(c + 2);
                __syncthreads();
            }
#undef S2_LOAD
#undef S2_WRITE
        } else {
            if (dir) s2_compute<1>(lds, OO, b, h, wave, lane); else s2_compute<0>(lds, OO, b, h, wave, lane);
        }
        __syncthreads();
    }
}

__device__ __forceinline__ void phase_post(const Args& a, int G) {
    const int tid = threadIdx.x, lane = tid & 63, wave = tid >> 6;
    unsigned char* ws = a.ws;
    const bf16 *SR = (const bf16*)(ws + WS_SR), *SK = (const bf16*)(ws + WS_SK), *SV = (const bf16*)(ws + WS_SV), *GG = (const bf16*)(ws + WS_GG);
    const bf16 *AF = (const bf16*)((unsigned char*)a.out + DO_AF), *AB = (const bf16*)((unsigned char*)a.out + DO_AB);
    const bf16 *OF = (const bf16*)((unsigned char*)a.out + DO_WF), *OB = (const bf16*)((unsigned char*)a.out + DO_WB);
    bf16* YB = (bf16*)(ws + WS_YB);
    const int gw = blockIdx.x * NWAVES + wave, NGW = G * NWAVES;
    for (int item = gw; item < 2 * NHEAD * (SEQ / 8); item += NGW) { const int tblk = item & (SEQ / 8 - 1), h = (item >> 9) & 15, b = item >> 13; const int c = h * 64 + lane;
        const unsigned o = bl_off(b, h, tblk, lane);
        const v4u qf = *(const v4u*)(OF + o), qb = *(const v4u*)(OB + o), qv = *(const v4u*)(SV + o), qg = *(const v4u*)(GG + o), qr = *(const v4u*)(SR + o), qk = *(const v4u*)(SK + o), qaf = *(const v4u*)(AF + o), qab = *(const v4u*)(AB + o);
        const float gng = a.in[I_GNG][c], gnb = a.in[I_GNB][c], ka = a.in[I_KA][c], rk = a.in[I_RK][c];
        float ov[8], mean[8], var[8], bs[8];
#pragma unroll
        for (int i = 0; i < 8; ++i) { const unsigned wf_ = qf[i >> 1], wb_ = qb[i >> 1]; ov[i] = (i & 1) ? bfhi(wf_) + bfhi(wb_) : bflo(wf_) + bflo(wb_); }
#pragma unroll
        for (int i = 0; i < 8; ++i) mean[i] = wave_sum(ov[i]) * (1.0f / 64.0f);
#pragma unroll
        for (int i = 0; i < 8; ++i) { ov[i] -= mean[i]; var[i] = wave_sum(ov[i] * ov[i]) * (1.0f / 64.0f); }
#pragma unroll
        for (int i = 0; i < 8; ++i) { const unsigned wr_ = qr[i >> 1], wk_ = qk[i >> 1], wa_ = qaf[i >> 1], wc_ = qab[i >> 1];
            const float r = (i & 1) ? bfhi(wr_) : bflo(wr_), k = (i & 1) ? bfhi(wk_) : bflo(wk_), af = (i & 1) ? bfhi(wa_) : bflo(wa_), ab = (i & 1) ? bfhi(wc_) : bflo(wc_);
            bs[i] = wave_sum(r * k * (2.0f + (af + ab - 2.0f) * ka) * rk); }
        bf16* yrow = YB + (size_t)(b * SEQ + tblk * 8) * RWW + c;
#pragma unroll
        for (int i = 0; i < 8; ++i) { const unsigned wv_ = qv[i >> 1], wg_ = qg[i >> 1]; const float v = (i & 1) ? bfhi(wv_) : bflo(wv_), g = (i & 1) ? bfhi(wg_) : bflo(wg_);
            const float y = ov[i] * __builtin_amdgcn_rsqf(var[i] + GN_EPS) * gng + gnb;
            yrow[(size_t)i * RWW] = (bf16)f2bf((y + bs[i] * v) * g); } }
}

__global__ void __launch_bounds__(NTHR, 2) fwd_kernel(Args a) {
    extern __shared__ __attribute__((aligned(16))) unsigned char lds_raw[];
    LAS unsigned char* lds = (LAS unsigned char*)lds_raw;
    const int G = gridDim.x, lo = a.ph_lo, hi = a.ph_hi;
    unsigned char* ws = a.ws;
    volatile LAS unsigned* barst = (volatile LAS unsigned*)(lds + LDS_BARST);
    if (threadIdx.x < 2) barst[threadIdx.x] = 0u;
    __syncthreads();
    XcdBarrier bar = xcd_barrier_post((unsigned*)(ws + WS_CTL), barst);
    unsigned long long* stamps = (unsigned long long*)(ws + WS_CTL + 32768);
#define STAMP(i) do { if (PROBE_TA != 0 && blockIdx.x == PROBE_BLK && threadIdx.x == 0) stamps[i] = __builtin_amdgcn_s_memrealtime(); } while (0)
    STAMP(0);
#define IN(k) (lo <= (k) && (k) < hi)
#define SEAM(k) do { if (IN(k) && IN((k) + 1)) { if (USE_CG_SYNC) cg::this_grid().sync(); else xcd_barrier(bar); } STAMP((k) + 1); } while (0)
    typedef pg8::bf16_t B;
    if (IN(0)) REP(0) { phase_prologue(a, lds, G); } SEAM(0);
    if (IN(1)) REP(1) { pg8::Gemm g{(const B*)(ws + WS_XB), (const B*)(ws + WS_WIN), MTOK, INWP, DM}; pg8::StaticOrder S; S.init(MTOK, INWP, G, (int)blockIdx.x);
        pg8::EpiIn E{(B*)(ws + WS_U), (B*)(ws + WS_VG), (B*)(ws + WS_FEAT), (B*)(ws + WS_MG), (B*)(ws + WS_SGB), (const float*)(ws + WS_RSTD1), (float*)(ws + WS_PART)};
        pg8::gemm_phase<pg8::EpiIn, pg8::StaticOrder, true, true>(lds, g, S, E);
        if ((int)blockIdx.x >= 192) convert_small_weights(a, lds, G - 192, 192); } SEAM(1);
    if (IN(2)) REP(2) { phase_sgu(a, lds, G); } STAMP(3); __syncthreads();
    STAMP(4);
    if (IN(4)) REP(4) { phase_prep(a, lds, G); } SEAM(4);
    if (IN(5)) REP(5) { if (S1_V2) phase_chunk_prep2(a, lds, G); else phase_chunk_prep(a, lds, G); xcd_barrier(bar); STAMP(15);
        if ((int)blockIdx.x < 64) phase_chunk_scan(a, lds, G);
        else { pg8::Gemm g{(const B*)(ws + WS_YA), (const B*)(ws + WS_WPA), MTOK, DM, SGW}; pg8::StaticOrder S; S.init(MTOK, DM, G - 64, (int)blockIdx.x - 64);
            pg8::EpiProj<0> E{(B*)(ws + WS_MG), nullptr};
            pg8::gemm_phase<pg8::EpiProj<0>, pg8::StaticOrder, true, true>(lds, g, S, E); } } SEAM(5);
    if (IN(6)) REP(6) { phase_post(a, G); phase_ffn_weights(a, lds, G); } SEAM(6);
    if (IN(7)) { pg8::Gemm g{(const B*)(ws + WS_YB), (const B*)(ws + WS_WPB), MTOK, DM, RWW}; pg8::StaticOrder S; S.init(MTOK, DM, G, (int)blockIdx.x);
        pg8::EpiProj<1> E{(B*)(ws + WS_MG), (const B*)(ws + WS_SGB)};
        pg8::gemm_phase<pg8::EpiProj<1>, pg8::StaticOrder, true, true>(lds, g, S, E, PROBE_TA != 0 ? stamps + 32 : nullptr); } SEAM(7);
    if (IN(8)) { pg8::Gemm g{(const B*)(ws + WS_MG), (const B*)(ws + WS_WOUT), MTOK, DM, DM}; pg8::StaticOrder S; S.init(MTOK, DM, G, (int)blockIdx.x);
        pg8::EpiOutNorm E{a.in[I_X], (B*)(ws + WS_X1B), (float*)(ws + WS_RSTD2), (float*)(ws + WS_XCH + 262144), (unsigned*)(ws + WS_CTL + CTL_CNT + 8192)};
        pg8::gemm_phase<pg8::EpiOutNorm, pg8::StaticOrder, false, true>(lds, g, S, E); } SEAM(8);
    STAMP(10);
    if (IN(10)) REP(10) { pg8::Gemm g{(const B*)(ws + WS_X1B), (const B*)(ws + WS_WG), MTOK, DFF, DM}; pg8::StaticOrder S; S.init(MTOK, DFF, G, (int)blockIdx.x);
        pg8::EpiGate E{(B*)(ws + WS_GT), (const float*)(ws + WS_RSTD2)};
        pg8::gemm_phase<pg8::EpiGate, pg8::StaticOrder, true, true>(lds, g, S, E);
        if ((int)blockIdx.x >= 192) convert_wup_tail(a, lds, G - 192, 192); } SEAM(10);
    if (IN(11)) REP(11) { pg8::Gemm g{(const B*)(ws + WS_X1B), (const B*)(ws + WS_WU), MTOK, DFF, DM}; pg8::StaticOrder S; S.init(MTOK, DFF, G, (int)blockIdx.x);
        pg8::EpiUp E{(const B*)(ws + WS_GT), (B*)(ws + WS_A3), (const float*)(ws + WS_RSTD2), a.in[I_CW], a.in[I_CB]};
        pg8::gemm_phase<pg8::EpiUp, pg8::StaticOrder, true, true>(lds, g, S, E);
        if ((int)blockIdx.x >= 192) convert_wdown_half(a, lds, -1, G - 192, 192); } SEAM(11);
    if (IN(12)) { pg8::Gemm g{(const B*)(ws + WS_A3), (const B*)(ws + WS_WD), MTOK, DM, DFF}; pg8::StaticOrder S; S.init(MTOK, DM, G, (int)blockIdx.x);
        if (G == 256) { pg8::EpiDownNorm E{(const B*)(ws + WS_X1B), a.out, a.in[I_NFG], (float*)(ws + WS_XCH), (unsigned*)(ws + WS_CTL + CTL_CNT)};
            pg8::gemm_phase<pg8::EpiDownNorm, pg8::StaticOrder, false, true>(lds, g, S, E); } }
    STAMP(13);
    if (PROBE_TA != 0 && blockIdx.x == PROBE_BLK) { STAMP(14); __threadfence(); __syncthreads();
        float ta = 0.f, tb = 0.f;
        for (int k = 0; k < 14; ++k) { const float d = (float)(stamps[k + 1] - stamps[k]) * 0.01f; if ((PROBE_TA >> k) & 1) ta += d; if ((PROBE_TB >> k) & 1) tb += d; }
        if (PROBE_TB == -1) tb = (float)(stamps[15] - stamps[5]) * 0.01f;
        if (PROBE_TB == -2) tb = (float)(stamps[13] - stamps[0]) * 0.01f - 1000.f;
        if (PROBE_TB <= -40) { const int q = -PROBE_TB - 40; tb = (float)(stamps[32 + q + 1] - stamps[32 + q]) * 0.01f; ta = (float)(stamps[32 + q + 2] - stamps[32 + q + 1]) * 0.01f; }
        else if (PROBE_TB <= -20) { tb = (float)stamps[-PROBE_TB] * 0.01f; ta = (float)stamps[-PROBE_TB + 1] * 0.01f; }
        if (threadIdx.x == 0) { a.out[0] = ta * (1.0f / PROBE_SA); if (PROBE_TB != 0) a.out[1] = tb * (1.0f / PROBE_SB); } }
#undef IN
#undef SEAM
}

extern "C" void kernel_launch(void* const* d_in, const int* in_sizes, int n_in, void* d_out, int out_size, void* d_ws, size_t ws_size, hipStream_t stream) {
    static int grid = 0;
    if (grid == 0) {
        if (n_in != 33 || out_size != MTOK * DM || ws_size < WS_END) { fprintf(stderr, "kernel_launch: unexpected shapes (n_in %d, out %d, ws %zu); nothing launched\n", n_in, out_size, ws_size); grid = -1; return; }
        int dev = 0, cus = 0, per_cu = 0;
        if (hipGetDevice(&dev) != hipSuccess || hipDeviceGetAttribute(&cus, hipDeviceAttributeMultiprocessorCount, dev) != hipSuccess) { grid = -1; return; }
        if (hipFuncSetAttribute((const void*)fwd_kernel, hipFuncAttributeMaxDynamicSharedMemorySize, LDS_BYTES) != hipSuccess) { fprintf(stderr, "kernel_launch: hipFuncSetAttribute failed\n"); grid = -1; return; }
        if (hipOccupancyMaxActiveBlocksPerMultiprocessor(&per_cu, (const void*)fwd_kernel, NTHR, LDS_BYTES) != hipSuccess || per_cu < 1) { fprintf(stderr, "kernel_launch: occupancy query says %d blocks per CU\n", per_cu); (void)hipGetLastError(); per_cu = 1; }
        grid = cus;
        if (grid != 256) { fprintf(stderr, "kernel_launch: built for a 256-CU device (grid %d)\n", grid); grid = -1; return; }
        if (grid < 128) { fprintf(stderr, "kernel_launch: needs >= 128 CUs (phase 5 splits the grid)\n"); grid = -1; return; }
    }
    if (grid < 0) return;
    if (hipMemsetAsync((char*)d_ws + WS_CTL, 0, CTL_ZERO_BYTES, stream) != hipSuccess) { fprintf(stderr, "kernel_launch: memset failed\n"); return; }
    Args a{};
    for (int i = 0; i < 33; ++i) a.in[i] = (const float*)d_in[i];
    a.out = (float*)d_out; a.ws = (unsigned char*)d_ws;
#if MK_SPLIT
    for (int p = 0; p < NPHASE; ++p) { a.ph_lo = p; a.ph_hi = p + 1; void* args[] = {&a};
        hipError_t e = hipLaunchCooperativeKernel((const void*)fwd_kernel, dim3(grid), dim3(NTHR), args, LDS_BYTES, stream);
        if (e != hipSuccess) { fprintf(stderr, "kernel_launch: launch of phase %d failed: %s\n", p, hipGetErrorString(e)); break; } }
#else
    a.ph_lo = 0; a.ph_hi = NPHASE; void* args[] = {&a};
    hipError_t e = hipLaunchCooperativeKernel((const void*)fwd_kernel, dim3(grid), dim3(NTHR), args, LDS_BYTES, stream);
    if (e != hipSuccess) fprintf(stderr, "kernel_launch: cooperative launch failed: %s (grid %d)\n", hipGetErrorString(e), grid);
#endif
}
```
